# Optimizing an MI355X kernel written in HIP

```python
import math
import jax
import jax.numpy as jnp
from jax import lax
import numpy as np

D_MODEL = 2048
BATCH = 4
SEQ = 4096
DEPTH = 4

HEAD_DIM = 128
FOX_HEADS = 4
DIFF_HEADS = 4
DIFF_HALF = HEAD_DIM // 2
NSA_HEADS = 8
NSA_KV_HEADS = 2
CMP_BLOCK = 32
CMP_STRIDE = 16
CMP_HIDDEN = 256
SEL_BLOCK = 64
SEL_TOPK = 16
WINDOW = 512
Q_BLOCK = 128
D_FF = ((8 * D_MODEL + 3 * 256 - 1) // (3 * 256)) * 256
FOX_WIDTH = FOX_HEADS * HEAD_DIM
DIFF_WIDTH = DIFF_HEADS * HEAD_DIM
NSA_WIDTH = NSA_HEADS * HEAD_DIM
NSA_KV_WIDTH = NSA_KV_HEADS * HEAD_DIM
MIX_WIDTH = FOX_WIDTH + DIFF_WIDTH + NSA_WIDTH
N_BRANCHES = 3
IN_SPLITS = (FOX_WIDTH, FOX_WIDTH, FOX_WIDTH, FOX_HEADS,
             DIFF_WIDTH, DIFF_WIDTH, DIFF_WIDTH,
             NSA_WIDTH, NSA_KV_WIDTH, NSA_KV_WIDTH, NSA_KV_WIDTH, NSA_KV_WIDTH,
             NSA_KV_WIDTH, NSA_KV_WIDTH, 3 * NSA_HEADS)
IN_COLS = sum(IN_SPLITS)
EPS = 1e-6
NEG_INF = -1e30
FORCE_SCORE = 1e4
FORGET_BIAS_CENTER = 3.0

kernel_name = "fox_diff_nsa_gated_hybrid"


def _rmsnorm(x, g):
    xf = x.astype(jnp.float32)
    y = xf * lax.rsqrt(jnp.mean(xf * xf, axis=-1, keepdims=True) + EPS)
    return (y * g.astype(jnp.float32)).astype(x.dtype)


def _alibi_slopes(n):
    return 2.0 ** (-8.0 * jnp.arange(1, n + 1, dtype=jnp.float32) / n)


def _split_cols(t, widths):
    out, start = [], 0
    for w in widths:
        out.append(t[..., start:start + w])
        start += w
    return out


def _heads(t, n):
    b, s, _ = t.shape
    return t.reshape(b, s, n, -1).transpose(0, 2, 1, 3)


def _merge_heads(t):
    b, n, s, d = t.shape
    return t.transpose(0, 2, 1, 3).reshape(b, s, n * d)


def _fox_attention(q, k, v, log_f):
    b, h, s, d = q.shape
    nb = s // Q_BLOCK
    scale = d ** -0.5
    cum = jnp.cumsum(log_f, axis=-1)
    kpos = jnp.arange(s)
    q_blk = q.reshape(b, h, nb, Q_BLOCK, d).transpose(2, 0, 1, 3, 4)
    c_blk = cum.reshape(b, h, nb, Q_BLOCK).transpose(2, 0, 1, 3)

    def block(args):
        i, qi, ci = args
        qpos = i * Q_BLOCK + jnp.arange(Q_BLOCK)
        sc = jnp.einsum('bhqd,bhkd->bhqk', qi, k).astype(jnp.float32) * scale
        sc = sc + ci[..., :, None] - cum[..., None, :]
        sc = jnp.where(kpos[None, :] <= qpos[:, None], sc, NEG_INF)
        p = jax.nn.softmax(sc, axis=-1).astype(v.dtype)
        return jnp.einsum('bhqk,bhkd->bhqd', p, v)

    o = lax.map(block, (jnp.arange(nb), q_blk, c_blk))
    return o.transpose(1, 2, 0, 3, 4).reshape(b, h, s, d)


def _diff_attention(q, k, v, lam, lam_init, slopes, subln):
    b, h, s, _, dh = q.shape
    d = v.shape[-1]
    nb = s // Q_BLOCK
    scale = dh ** -0.5
    kpos = jnp.arange(s)
    sl = slopes[None, :, None, None, None]
    q_blk = q.reshape(b, h, nb, Q_BLOCK, 2, dh).transpose(2, 0, 1, 3, 4, 5)

    def block(args):
        i, qi = args
        qpos = i * Q_BLOCK + jnp.arange(Q_BLOCK)
        dist = qpos[:, None] - kpos[None, :]
        sc = jnp.einsum('bhqcd,bhkcd->bhcqk', qi, k).astype(jnp.float32) * scale
        sc = jnp.where(dist >= 0, sc - sl * dist.astype(jnp.float32), NEG_INF)
        p = jax.nn.softmax(sc, axis=-1)
        a = p[:, :, 0] - lam * p[:, :, 1]
        return jnp.einsum('bhqk,bhkd->bhqd', a.astype(v.dtype), v)

    o = lax.map(block, (jnp.arange(nb), q_blk))
    o = o.transpose(1, 2, 0, 3, 4).reshape(b, h, s, d)
    return _rmsnorm(o, subln) * (1.0 - lam_init)


def _compress(kv, pos, w1, w2):
    s = kv.shape[2]
    nc = (s - CMP_BLOCK) // CMP_STRIDE + 1
    idx = jnp.arange(nc)[:, None] * CMP_STRIDE + jnp.arange(CMP_BLOCK)[None, :]
    blocks = kv[:, :, idx, :] + pos
    flat = blocks.reshape(blocks.shape[0], blocks.shape[1], nc, CMP_BLOCK * HEAD_DIM)
    return jax.nn.silu(flat @ w1) @ w2


def _nsa_attention(q, k_c, v_c, k_s, v_s, k_w, v_w, gates, slopes):
    b, h, s, d = q.shape
    g = k_s.shape[1]
    r = h // g
    nb = s // Q_BLOCK
    nc = k_c.shape[2]
    nsel = s // SEL_BLOCK
    topk = min(SEL_TOPK, nsel)
    scale = d ** -0.5
    cmp_start = jnp.arange(nc) * CMP_STRIDE
    cmp_end = cmp_start + CMP_BLOCK - 1
    sel_start = jnp.arange(nsel) * SEL_BLOCK
    overlap = ((cmp_start[:, None] < sel_start[None, :] + SEL_BLOCK)
               & (cmp_end[:, None] >= sel_start[None, :])).astype(jnp.float32)
    blk_id = jnp.arange(nsel)
    sl = slopes.reshape(g, r)[None, :, :, None, None]
    q_blk = q.reshape(b, g, r, nb, Q_BLOCK, d).transpose(3, 0, 1, 2, 4, 5)
    g_blk = gates.reshape(b, g, r, nb, Q_BLOCK, 3).transpose(3, 0, 1, 2, 4, 5)
    pad = jnp.zeros((b, g, WINDOW, d), k_w.dtype)
    kw_pad = jnp.concatenate([pad, k_w], axis=2)
    vw_pad = jnp.concatenate([pad, v_w], axis=2)
    bi = jnp.arange(b)[:, None, None, None]
    gidx = jnp.arange(g)[None, :, None, None]

    def block(args):
        i, qi, gate_i = args
        qpos = i * Q_BLOCK + jnp.arange(Q_BLOCK)
        dist_c = qpos[:, None] - cmp_end[None, :]
        valid_c = dist_c >= 0
        sc = jnp.einsum('bgrqd,bgcd->bgrqc', qi, k_c).astype(jnp.float32) * scale
        sc = jnp.where(valid_c, sc - sl * dist_c.astype(jnp.float32), NEG_INF)
        p_c = jax.nn.softmax(sc, axis=-1) * jnp.any(valid_c, axis=-1)[:, None]
        o_cmp = jnp.einsum('bgrqc,bgcd->bgrqd', p_c.astype(v_c.dtype), v_c)
        imp = jnp.einsum('bgrqc,cj->bgqj', p_c, overlap)
        cur = qpos // SEL_BLOCK
        valid_s = blk_id[None, :] <= cur[:, None]
        forced = ((blk_id[None, :] == 0) | (blk_id[None, :] == cur[:, None])
                  | (blk_id[None, :] == cur[:, None] - 1))
        imp = jnp.where(valid_s, jnp.where(forced, FORCE_SCORE, imp), -1.0)
        _, top = lax.top_k(imp, topk)
        tok = (top[..., None] * SEL_BLOCK + jnp.arange(SEL_BLOCK)).reshape(b, g, Q_BLOCK, topk * SEL_BLOCK)
        ks = k_s[bi, gidx, tok]
        vs = v_s[bi, gidx, tok]
        dist_s = (qpos[None, None, :, None] - tok)[:, :, None]
        ss = jnp.einsum('bgrqd,bgqnd->bgrqn', qi, ks).astype(jnp.float32) * scale
        ss = jnp.where(dist_s >= 0, ss - sl * dist_s.astype(jnp.float32), NEG_INF)
        o_sel = jnp.einsum('bgrqn,bgqnd->bgrqd', jax.nn.softmax(ss, axis=-1).astype(vs.dtype), vs)
        kw = lax.dynamic_slice_in_dim(kw_pad, i * Q_BLOCK, WINDOW + Q_BLOCK, axis=2)
        vw = lax.dynamic_slice_in_dim(vw_pad, i * Q_BLOCK, WINDOW + Q_BLOCK, axis=2)
        kpos = i * Q_BLOCK - WINDOW + jnp.arange(WINDOW + Q_BLOCK)
        dist_w = qpos[:, None] - kpos[None, :]
        valid_w = (dist_w >= 0) & (dist_w < WINDOW) & (kpos[None, :] >= 0)
        sw = jnp.einsum('bgrqd,bgkd->bgrqk', qi, kw).astype(jnp.float32) * scale
        sw = jnp.where(valid_w, sw - sl * dist_w.astype(jnp.float32), NEG_INF)
        o_win = jnp.einsum('bgrqk,bgkd->bgrqd', jax.nn.softmax(sw, axis=-1).astype(vw.dtype), vw)
        return gate_i[..., 0:1] * o_cmp + gate_i[..., 1:2] * o_sel + gate_i[..., 2:3] * o_win

    o = lax.map(block, (jnp.arange(nb), q_blk, g_blk))
    return o.transpose(1, 2, 3, 0, 4, 5).reshape(b, h, s, d)


def _hybrid_mixer(h, w_in, f_bias, lam_vec, subln, cmp_pos, cmp_w1, cmp_w2,
                  wb_fox, wb_diff, wb_nsa, w_gate, w_out, lam_init):
    b, s, _ = h.shape
    (fq, fk, fv, ff, dq, dk, dv, nq, nkc, nvc, nks, nvs, nkw, nvw, ng) = _split_cols(h @ w_in, IN_SPLITS)
    log_f = jax.nn.log_sigmoid(ff.astype(jnp.float32) + f_bias.astype(jnp.float32)).transpose(0, 2, 1)
    o_fox = _fox_attention(_heads(fq, FOX_HEADS), _heads(fk, FOX_HEADS), _heads(fv, FOX_HEADS), log_f)
    lv = lam_vec.astype(jnp.float32)
    lam = jnp.exp(jnp.sum(lv[0] * lv[1])) - jnp.exp(jnp.sum(lv[2] * lv[3])) + lam_init
    dq2 = dq.reshape(b, s, DIFF_HEADS, 2, DIFF_HALF).transpose(0, 2, 1, 3, 4)
    dk2 = dk.reshape(b, s, DIFF_HEADS, 2, DIFF_HALF).transpose(0, 2, 1, 3, 4)
    o_diff = _diff_attention(dq2, dk2, _heads(dv, DIFF_HEADS), lam, lam_init,
                             _alibi_slopes(DIFF_HEADS), subln)
    k_cmp = _compress(_heads(nkc, NSA_KV_HEADS), cmp_pos[0], cmp_w1[0], cmp_w2[0])
    v_cmp = _compress(_heads(nvc, NSA_KV_HEADS), cmp_pos[1], cmp_w1[1], cmp_w2[1])
    nsa_gates = jax.nn.sigmoid(ng).reshape(b, s, NSA_HEADS, 3).transpose(0, 2, 1, 3)
    o_nsa = _nsa_attention(_heads(nq, NSA_HEADS), k_cmp, v_cmp,
                           _heads(nks, NSA_KV_HEADS), _heads(nvs, NSA_KV_HEADS),
                           _heads(nkw, NSA_KV_HEADS), _heads(nvw, NSA_KV_HEADS),
                           nsa_gates, _alibi_slopes(NSA_HEADS))
    y_fox = _merge_heads(o_fox) @ wb_fox
    y_diff = _merge_heads(o_diff) @ wb_diff
    y_nsa = _merge_heads(o_nsa) @ wb_nsa
    gate = jax.nn.sigmoid(h @ w_gate).reshape(b, s, N_BRANCHES, D_MODEL)
    merged = gate[:, :, 0] * y_fox + gate[:, :, 1] * y_diff + gate[:, :, 2] * y_nsa
    return merged @ w_out


def _swiglu(h, w_up, w_down):
    gate, up = _split_cols(h @ w_up, (D_FF, D_FF))
    return (jax.nn.silu(gate) * up) @ w_down


def setup_inputs(seed: int = 0) -> dict:
    key = jax.random.key(seed)
    ks = jax.random.split(key, 16)
    L, D = DEPTH, D_MODEL

    def nrm(k, shape, scale):
        return jax.random.normal(k, shape, jnp.float32) * scale

    return {
        "x": nrm(ks[0], (BATCH, SEQ, D), 1.0),
        "w_in": nrm(ks[1], (L, D, IN_COLS), D ** -0.5),
        "fox_forget_bias": FORGET_BIAS_CENTER + nrm(ks[2], (L, FOX_HEADS), 0.5),
        "diff_lambda": nrm(ks[3], (L, 4, DIFF_HALF), 0.1),
        "diff_subln": 1.0 + nrm(ks[4], (L, HEAD_DIM), 0.05),
        "nsa_cmp_pos": nrm(ks[5], (L, 2, CMP_BLOCK, HEAD_DIM), 0.1),
        "nsa_cmp_w1": nrm(ks[6], (L, 2, CMP_BLOCK * HEAD_DIM, CMP_HIDDEN), (CMP_BLOCK * HEAD_DIM) ** -0.5),
        "nsa_cmp_w2": nrm(ks[7], (L, 2, CMP_HIDDEN, HEAD_DIM), CMP_HIDDEN ** -0.5),
        "w_branch_fox": nrm(ks[8], (L, FOX_WIDTH, D), FOX_WIDTH ** -0.5),
        "w_branch_diff": nrm(ks[9], (L, DIFF_WIDTH, D), DIFF_WIDTH ** -0.5),
        "w_branch_nsa": nrm(ks[10], (L, NSA_WIDTH, D), NSA_WIDTH ** -0.5),
        "w_gate": nrm(ks[11], (L, D, N_BRANCHES * D), D ** -0.5),
        "w_out": nrm(ks[12], (L, D, D), D ** -0.5),
        "norm_gains": 1.0 + nrm(ks[13], (L, 4, D), 0.05),
        "w_ffn_up": nrm(ks[14], (L, D, 2 * D_FF), D ** -0.5),
        "w_ffn_down": nrm(ks[15], (L, D_FF, D), D_FF ** -0.5),
    }


def reference(x, w_in, fox_forget_bias, diff_lambda, diff_subln, nsa_cmp_pos, nsa_cmp_w1, nsa_cmp_w2,
              w_branch_fox, w_branch_diff, w_branch_nsa, w_gate, w_out, norm_gains, w_ffn_up, w_ffn_down):
    for l in range(DEPTH):
        lam_init = 0.8 - 0.6 * math.exp(-0.3 * l)
        h = _rmsnorm(x, norm_gains[l, 0])
        y = _hybrid_mixer(h, w_in[l], fox_forget_bias[l], diff_lambda[l], diff_subln[l],
                          nsa_cmp_pos[l], nsa_cmp_w1[l], nsa_cmp_w2[l],
                          w_branch_fox[l], w_branch_diff[l], w_branch_nsa[l],
                          w_gate[l], w_out[l], lam_init)
        x = x + _rmsnorm(y, norm_gains[l, 1])
        h = _rmsnorm(x, norm_gains[l, 2])
        x = x + _rmsnorm(_swiglu(h, w_ffn_up[l], w_ffn_down[l]), norm_gains[l, 3])
    return x
```

```cpp
#include <hip/hip_runtime.h>
#include <cstdio>
#include <cstdint>
#include <cmath>

#define LAS __attribute__((address_space(3)))
typedef unsigned short bf16_t;
typedef short bf16x8 __attribute__((ext_vector_type(8)));
typedef short s16x4 __attribute__((ext_vector_type(4)));
typedef float f32x4 __attribute__((ext_vector_type(4)));
typedef float f32x16 __attribute__((ext_vector_type(16)));
typedef unsigned u32x4 __attribute__((ext_vector_type(4)));
typedef unsigned u32x2 __attribute__((ext_vector_type(2)));

constexpr int T = 16384, DM = 2048, NBATCH = 4, SEQ = 4096, NLAYER = 4;
constexpr int IN_COLS = 5660, DFF = 5632, HD = 128;
constexpr int N1 = 12032;
constexpr int NSLOT = 44;
constexpr float EPS = 1e-6f;

constexpr int SL_FQ = 0, SL_FK = 4, SL_FV = 8, SL_DQ = 12, SL_DK = 16, SL_DV = 20, SL_NQ = 24, SL_NKC = 32, SL_NVC = 34, SL_NKS = 36, SL_NVS = 38, SL_NKW = 40, SL_NVW = 42;

constexpr size_t al256(size_t x) { return (x + 255) & ~(size_t)255; }
constexpr size_t WS_CTL   = 0;
constexpr size_t CTL_BYTES = 65536;
constexpr size_t W1T_EL  = (size_t)N1 * DM;
constexpr size_t WBT_EL  = (size_t)DM * DM;
constexpr size_t WOT_EL  = (size_t)DM * DM;
constexpr size_t WUP_EL  = (size_t)2 * DFF * DM;
constexpr size_t WDN_EL  = (size_t)DM * DFF;
constexpr size_t WC1_EL  = (size_t)2 * 256 * 4096;
constexpr size_t LW_EL   = W1T_EL + WBT_EL + WOT_EL + WUP_EL + WDN_EL + WC1_EL;
constexpr size_t OFF_W1T = 0, OFF_WBT = OFF_W1T + W1T_EL, OFF_WOT = OFF_WBT + WBT_EL, OFF_WUP = OFF_WOT + WOT_EL, OFF_WDN = OFF_WUP + WUP_EL, OFF_WC1 = OFF_WDN + WDN_EL;
constexpr size_t WS_W     = WS_CTL + CTL_BYTES;
constexpr size_t WS_POSB  = al256(WS_W + (size_t)NLAYER * LW_EL * 2);
constexpr size_t WS_HB    = al256(WS_POSB + (size_t)NLAYER * 2 * 256 * 4);
constexpr size_t WS_QKV   = al256(WS_HB + (size_t)T * DM * 2);
constexpr size_t QKV_BYTES = (size_t)NSLOT * NBATCH * SEQ * HD * 2;
constexpr size_t WS_GATES = al256(WS_QKV + QKV_BYTES + 65536);
constexpr size_t WS_HID   = WS_QKV;
constexpr size_t WS_ATT   = al256(WS_GATES + (size_t)3 * T * DM * 2);
constexpr size_t WS_MRG   = al256(WS_ATT + (size_t)T * DM * 2);
constexpr size_t WS_Y     = al256(WS_MRG + (size_t)T * DM * 2);
constexpr size_t WS_LOGF  = al256(WS_Y + (size_t)T * DM * 4);
constexpr size_t WS_NSAG  = al256(WS_LOGF + (size_t)T * 4 * 4);
constexpr size_t WS_CUM   = al256(WS_NSAG + (size_t)T * 24 * 4);
constexpr size_t WS_H1    = al256(WS_CUM + (size_t)16 * SEQ * 4);
constexpr size_t WS_KVC   = al256(WS_H1 + (size_t)16 * 256 * 256 * 2);
constexpr size_t WS_SELM  = al256(WS_KVC + (size_t)16 * 256 * 128 * 2);
constexpr size_t WS_END   = al256(WS_SELM + (size_t)NBATCH * 2 * SEQ * 8);
static_assert((size_t)T * DFF * 2 <= (WS_ATT - WS_QKV), "HID overlay must fit in QKV + GATES");

__device__ __forceinline__ float bf2f(bf16_t b) { return __uint_as_float(((unsigned)b) << 16); }
__device__ __forceinline__ bf16_t f2bf(float f) { unsigned u = __float_as_uint(f); u += 0x7FFFu + ((u >> 16) & 1u); return (bf16_t)(u >> 16); }
__device__ __forceinline__ unsigned cvt_pk_bf16(float lo, float hi) { unsigned r; asm volatile("v_cvt_pk_bf16_f32 %0, %1, %2" : "=v"(r) : "v"(lo), "v"(hi)); return r; }
__device__ __forceinline__ float sigmoidf_(float v) { return __builtin_amdgcn_rcpf(1.0f + __expf(-v)); }
__device__ __forceinline__ float wave_sum(float v) {
#pragma unroll
    for (int o = 1; o < 64; o <<= 1) v += __shfl_xor(v, o);
    return v;
}
__device__ __forceinline__ float wave_max(float v) {
#pragma unroll
    for (int o = 1; o < 64; o <<= 1) v = fmaxf(v, __shfl_xor(v, o));
    return v;
}

namespace pg8 {
constexpr int BM = 256, BK = 64, HALF = 128, HTB = HALF * BK * 2, STAGE_BYTES = 8 * HTB, NXCD = 8, WGM = 8;
__host__ __device__ __forceinline__ int lds_byte(int r, int c) { const int st = (r >> 4) * 2 + (c >> 5), rr = r & 15, cc = c & 31, ob = rr * 64 + cc * 2; return st * 1024 + (ob ^ (((ob >> 9) & 1) << 5)); }
__host__ __device__ __forceinline__ void stage_rc(int b, int& R, int& C) { const int st = b / 1024, sb = b % 1024, swz = sb ^ (((sb >> 9) & 1) << 5); R = (st >> 1) * 16 + swz / 64; C = (st & 1) * 32 + (swz % 64) / 2; }
__host__ __device__ __forceinline__ int perm32(int rho) { const int n = rho >> 4, i = rho & 15; return 8 * (i >> 2) + 4 * n + (i & 3); }

struct Unit { int pm, pn; };
struct Gemm { const bf16_t* A; const bf16_t* Bt; int M, N, K, lda, ldb, pad; };

struct StaticOrder {
    int nM, nN, nwg, G, c;
    __host__ __device__ void init(int M, int N, int G_, int c_) { nM = M / BM; nN = N / BM; nwg = nM * nN; G = G_; c = c_; }
    __host__ __device__ bool next(int i, Unit& u) const {
        const long L = (long)i * G + c; if (L >= nwg) return false;
        int wgid = (int)L; { const int q = nwg / NXCD, r = nwg % NXCD, xcd = wgid % NXCD, off = wgid / NXCD; wgid = (xcd < r ? xcd * (q + 1) : r * (q + 1) + (xcd - r) * q) + off; }
        const int nig = WGM * nN, gid = wgid / nig, fm = gid * WGM, gsz = (nM - fm) < WGM ? (nM - fm) : WGM;
        u.pm = fm + ((wgid % nig) % gsz); u.pn = (wgid % nig) / gsz; return true;
    }
};
struct CmpOrder {
    int G, c;
    __host__ __device__ void init(int, int, int G_, int c_) { G = G_; c = c_; }
    __host__ __device__ bool next(int i, Unit& u) const { const int Lx = i * G + c; if (Lx >= 16) return false; u.pm = Lx; u.pn = Lx >> 3; return true; }
};

typedef f32x4 Acc[2][2][4][2];

template <class Epi, class Sched>
__device__ __forceinline__ void gemm_phase(LAS unsigned char* lds, const Gemm g, const Sched& S, const Epi& E) {
    const int tid = threadIdx.x, wid = __builtin_amdgcn_readfirstlane(tid >> 6), lane = tid & 63, wr = wid >> 2, wc = wid & 3, fr = lane & 15, fq = lane >> 4;
    const int K = g.K, nt = K / BK;
    unsigned voffA[2], voffB[2];
#pragma unroll
    for (int i = 0; i < 2; ++i) { int R, C; stage_rc(tid * 16 + i * 8192, R, C); const int Rb = Epi::PERM ? ((R & ~31) + perm32(R & 31)) : R;
        voffA[i] = (unsigned)(R * g.lda + C) * 2u; voffB[i] = (unsigned)(Rb * g.ldb + C) * 2u; }
    const size_t kstep = (size_t)(BK * 2);
    const size_t hstepA = (size_t)HALF * g.lda * 2, hstepB = (size_t)HALF * g.ldb * 2;
    const size_t tstepA = 2 * hstepA, tstepB = 2 * hstepB;
    const unsigned ldsw = (unsigned)wid * 1024u;
    const int aoff = lds_byte(wr * 64 + fr, fq * 8), boff = lds_byte(wc * 32 + fr, fq * 8);
#define PG8_SA(b, h) (((b) * 2 + (h)) * HTB)
#define PG8_SB(b, h) ((4 + (b) * 2 + (h)) * HTB)
#define PG8_STAGE(bufoff, gbase, voff) do { _Pragma("unroll") for (int _i = 0; _i < 2; ++_i) \
        __builtin_amdgcn_global_load_lds((const unsigned*)((const char*)(gbase) + (voff)[_i]), (LAS unsigned*)(lds + (bufoff) + ldsw + _i * 8192), 16, 0, 0); } while (0)
#define PG8_LDA(dst, b, h) do { _Pragma("unroll") for (int m = 0; m < 4; ++m) _Pragma("unroll") for (int k = 0; k < 2; ++k) dst[m][k] = *(const LAS bf16x8*)(lds + PG8_SA(b, h) + aoff + m * 2048 + k * 1024); } while (0)
#define PG8_LDB(dst, b, h) do { _Pragma("unroll") for (int n = 0; n < 2; ++n) _Pragma("unroll") for (int k = 0; k < 2; ++k) dst[n][k] = *(const LAS bf16x8*)(lds + PG8_SB(b, h) + boff + n * 2048 + k * 1024); } while (0)
#define PG8_MMA(ai, bj, At, Bt) do { __builtin_amdgcn_s_setprio(1); _Pragma("unroll") for (int m = 0; m < 4; ++m) _Pragma("unroll") for (int n = 0; n < 2; ++n) _Pragma("unroll") for (int k = 0; k < 2; ++k) \
        acc[ai][bj][m][n] = __builtin_amdgcn_mfma_f32_16x16x32_bf16(Bt[n][k], At[m][k], acc[ai][bj][m][n], 0, 0, 0); __builtin_amdgcn_s_setprio(0); } while (0)
#define PG8_WAIT_V(n) asm volatile("s_waitcnt vmcnt(" #n ")" ::: "memory")
#define PG8_WAIT_L(n) asm volatile("s_waitcnt lgkmcnt(" #n ")" ::: "memory")
#define PG8_BAR __builtin_amdgcn_s_barrier()
#define PG8_SCHED __builtin_amdgcn_sched_barrier(0)
    Unit cur, nxt; int ui = 0;
    if (!S.next(0, cur)) return;
    f32x4 acc[2][2][4][2];
#pragma unroll
    for (int a = 0; a < 2; ++a)
#pragma unroll
        for (int b = 0; b < 2; ++b)
#pragma unroll
            for (int m = 0; m < 4; ++m)
#pragma unroll
                for (int n = 0; n < 2; ++n) acc[a][b][m][n] = (f32x4){0.f, 0.f, 0.f, 0.f};
    bf16x8 At[4][2], B0[2][2], B1[2][2];
    const char* cA = (const char*)g.A + (size_t)cur.pm * tstepA; const char* cB = (const char*)g.Bt + (size_t)cur.pn * tstepB;
    PG8_STAGE(PG8_SB(0, 0), cB, voffB); PG8_STAGE(PG8_SA(0, 0), cA, voffA); PG8_STAGE(PG8_SB(0, 1), cB + hstepB, voffB); PG8_STAGE(PG8_SA(0, 1), cA + hstepA, voffA);
    if (wr == 1) PG8_BAR;
    PG8_WAIT_V(4); PG8_BAR;
    PG8_STAGE(PG8_SB(1, 0), cB + kstep, voffB); PG8_STAGE(PG8_SA(1, 0), cA + kstep, voffA); PG8_STAGE(PG8_SB(1, 1), cB + hstepB + kstep, voffB);
    PG8_WAIT_V(6); PG8_BAR;
    for (;;) {
        const bool has_next = S.next(ui + 1, nxt);
        const char* nA = has_next ? (const char*)g.A + (size_t)nxt.pm * tstepA : cA; const char* nB = has_next ? (const char*)g.Bt + (size_t)nxt.pn * tstepB : cB;
        for (int t = 0; t < nt; t += 2) {
            if constexpr (Epi::HOOK) { if (t == Epi::H1 || t == Epi::H2) E.mid(acc, cur, t, wr, wc, fr, fq); }
            const bool last = (t == nt - 2);
            const char* a1 = cA + (size_t)(t + 1) * kstep;
            const char* a2 = last ? nA : cA + (size_t)(t + 2) * kstep; const char* b2 = last ? nB : cB + (size_t)(t + 2) * kstep;
            const char* a3 = a2 + kstep; const char* b3 = b2 + kstep;
            PG8_LDB(B0, 0, 0); PG8_SCHED; PG8_LDA(At, 0, 0); PG8_STAGE(PG8_SA(1, 1), a1 + hstepA, voffA);
            PG8_WAIT_L(8); PG8_BAR; PG8_WAIT_L(0); PG8_MMA(0, 0, At, B0); PG8_BAR; PG8_SCHED;
            PG8_LDB(B1, 0, 1); PG8_STAGE(PG8_SB(0, 0), b2, voffB);
            PG8_BAR; PG8_WAIT_L(0); PG8_MMA(0, 1, At, B1); PG8_BAR;
            PG8_LDA(At, 0, 1); PG8_STAGE(PG8_SA(0, 0), a2, voffA);
            PG8_BAR; PG8_WAIT_L(0); PG8_MMA(1, 0, At, B0); PG8_BAR; PG8_SCHED;
            PG8_STAGE(PG8_SB(0, 1), b2 + hstepB, voffB);
            PG8_WAIT_V(6); PG8_BAR; PG8_MMA(1, 1, At, B1); PG8_BAR;
            PG8_LDB(B0, 1, 0); PG8_SCHED; PG8_LDA(At, 1, 0); PG8_STAGE(PG8_SA(0, 1), a2 + hstepA, voffA);
            PG8_WAIT_L(8); PG8_BAR; PG8_WAIT_L(0); PG8_MMA(0, 0, At, B0); PG8_BAR; PG8_SCHED;
            PG8_LDB(B1, 1, 1); PG8_STAGE(PG8_SB(1, 0), b3, voffB);
            PG8_BAR; PG8_WAIT_L(0); PG8_MMA(0, 1, At, B1); PG8_BAR;
            PG8_LDA(At, 1, 1); PG8_STAGE(PG8_SA(1, 0), a3, voffA);
            PG8_BAR; PG8_WAIT_L(0); PG8_MMA(1, 0, At, B0); PG8_BAR; PG8_SCHED;
            PG8_STAGE(PG8_SB(1, 1), b3 + hstepB, voffB);
            PG8_WAIT_V(6); PG8_BAR; PG8_MMA(1, 1, At, B1); PG8_BAR;
        }
        E(acc, cur, wr, wc, fr, fq);
        if (!has_next) break;
#pragma unroll
        for (int a = 0; a < 2; ++a)
#pragma unroll
            for (int b = 0; b < 2; ++b)
#pragma unroll
                for (int m = 0; m < 4; ++m)
#pragma unroll
                    for (int n = 0; n < 2; ++n) acc[a][b][m][n] = (f32x4){0.f, 0.f, 0.f, 0.f};
        cur = nxt; cA = nA; cB = nB; ++ui;
    }
    PG8_WAIT_V(0);
    if (wr == 0) PG8_BAR;
    PG8_BAR;
#undef PG8_SA
#undef PG8_SB
#undef PG8_STAGE
#undef PG8_LDA
#undef PG8_LDB
#undef PG8_MMA
#undef PG8_WAIT_V
#undef PG8_WAIT_L
#undef PG8_BAR
#undef PG8_SCHED
}

__device__ __forceinline__ u32x4 pack8(const f32x4 v0, const f32x4 v1) { u32x4 w; w.x = cvt_pk_bf16(v0[0], v0[1]); w.y = cvt_pk_bf16(v0[2], v0[3]); w.z = cvt_pk_bf16(v1[0], v1[1]); w.w = cvt_pk_bf16(v1[2], v1[3]); return w; }

struct Epi1 {
    static constexpr bool PERM = true, HOOK = false; static constexpr int H1 = -1, H2 = -1;
    bf16_t* qkv; float* logf; float* nsag; bf16_t* gates; const float* fbias;
    __device__ __forceinline__ void operator()(const Acc& acc, const Unit& u, int wr, int wc, int fr, int fq) const {
        const int row0 = u.pm * BM + wr * 64 + fr;
        if (u.pn < 22) {
#pragma unroll
            for (int ai = 0; ai < 2; ++ai)
#pragma unroll
                for (int m = 0; m < 4; ++m) { const int r = row0 + ai * HALF + m * 16, b = r >> 12, s = r & 4095;
#pragma unroll
                    for (int bj = 0; bj < 2; ++bj) { const int slot = 2 * u.pn + bj;
                        bf16_t* dst = qkv + (((size_t)(slot * 4 + b) * SEQ + s) * HD + wc * 32 + 8 * fq);
                        *(u32x4*)dst = pack8(acc[ai][bj][m][0], acc[ai][bj][m][1]); } }
        } else if (u.pn == 22) {
            if (wc == 0) {
#pragma unroll
                for (int ai = 0; ai < 2; ++ai)
#pragma unroll
                    for (int m = 0; m < 4; ++m) { const int r = row0 + ai * HALF + m * 16;
#pragma unroll
                        for (int n = 0; n < 2; ++n)
#pragma unroll
                            for (int i = 0; i < 4; ++i) { const int c = 8 * fq + 4 * n + i; const float v = acc[ai][0][m][n][i];
                                if (c < 4) { const float z = v + fbias[c]; logf[(size_t)r * 4 + c] = fminf(z, 0.f) - log1pf(expf(-fabsf(z))); }
                                else if (c < 28) nsag[(size_t)r * 24 + (c - 4)] = 1.0f / (1.0f + expf(-v)); } }
            }
        } else {
            const int pg = u.pn - 23, bidx = pg >> 3, colt = (pg & 7) * 256;
#pragma unroll
            for (int ai = 0; ai < 2; ++ai)
#pragma unroll
                for (int m = 0; m < 4; ++m) { const int r = row0 + ai * HALF + m * 16;
#pragma unroll
                    for (int bj = 0; bj < 2; ++bj) { f32x4 v0 = acc[ai][bj][m][0], v1 = acc[ai][bj][m][1];
#pragma unroll
                        for (int i = 0; i < 4; ++i) { v0[i] = fmaxf(sigmoidf_(v0[i]), 1e-20f); v1[i] = fmaxf(sigmoidf_(v1[i]), 1e-20f); }
                        bf16_t* dst = gates + (((size_t)bidx * T + r) * DM + colt + bj * HALF + wc * 32 + 8 * fq);
                        *(u32x4*)dst = pack8(v0, v1); } }
        }
    }
};

struct Epi2 {
    static constexpr bool PERM = true, HOOK = true; static constexpr int H1 = 8, H2 = 16;
    const bf16_t* gates; bf16_t* out;
    __device__ __forceinline__ void mid(Acc& acc, const Unit& u, int t, int wr, int wc, int fr, int fq) const {
        int row0 = u.pm * BM + wr * 64 + fr; asm volatile("" : "+v"(row0));
        const bf16_t* ga = gates + (t == H1 ? (size_t)0 : (size_t)T * DM); const bf16_t* gb = ga + (size_t)T * DM;
#pragma unroll
        for (int ai = 0; ai < 2; ++ai)
#pragma unroll
            for (int m = 0; m < 4; ++m) { const int r = row0 + ai * HALF + m * 16;
#pragma unroll
                for (int bj = 0; bj < 2; ++bj) { const size_t o = (size_t)r * DM + u.pn * BM + bj * HALF + wc * 32 + 8 * fq;
                    const bf16x8 a = *(const bf16x8*)(ga + o), b = *(const bf16x8*)(gb + o);
#pragma unroll
                    for (int e = 0; e < 8; ++e) { const float ra = bf2f((bf16_t)a[e]) * __builtin_amdgcn_rcpf(bf2f((bf16_t)b[e])); acc[ai][bj][m][e >> 2][e & 3] *= ra; } }
                __builtin_amdgcn_sched_barrier(0); }
    }
    __device__ __forceinline__ void operator()(const Acc& acc, const Unit& u, int wr, int wc, int fr, int fq) const {
        const int row0 = u.pm * BM + wr * 64 + fr; const bf16_t* g2 = gates + (size_t)2 * T * DM;
#pragma unroll
        for (int ai = 0; ai < 2; ++ai)
#pragma unroll
            for (int m = 0; m < 4; ++m) { const int r = row0 + ai * HALF + m * 16;
#pragma unroll
                for (int bj = 0; bj < 2; ++bj) { const size_t o = (size_t)r * DM + u.pn * BM + bj * HALF + wc * 32 + 8 * fq;
                    const bf16x8 gg = *(const bf16x8*)(g2 + o); f32x4 v0 = acc[ai][bj][m][0], v1 = acc[ai][bj][m][1];
#pragma unroll
                    for (int i = 0; i < 4; ++i) { v0[i] *= bf2f((bf16_t)gg[i]); v1[i] *= bf2f((bf16_t)gg[4 + i]); }
                    *(u32x4*)(out + o) = pack8(v0, v1); } }
    }
};

struct EpiF32 {
    static constexpr bool PERM = false, HOOK = false; static constexpr int H1 = -1, H2 = -1;
    float* C; int ldc; int pad;
    __device__ __forceinline__ void operator()(const Acc& acc, const Unit& u, int wr, int wc, int fr, int fq) const {
        const int row0 = u.pm * BM + wr * 64 + fr, col0 = u.pn * BM + wc * 32 + 4 * fq;
#pragma unroll
        for (int ai = 0; ai < 2; ++ai)
#pragma unroll
            for (int m = 0; m < 4; ++m) { float* rowp = C + (size_t)(row0 + ai * HALF + m * 16) * ldc + col0;
#pragma unroll
                for (int bj = 0; bj < 2; ++bj)
#pragma unroll
                    for (int n = 0; n < 2; ++n) *(f32x4*)(rowp + bj * HALF + n * 16) = acc[ai][bj][m][n]; }
    }
};

struct EpiSwiGLU {
    static constexpr bool PERM = true, HOOK = false; static constexpr int H1 = -1, H2 = -1;
    bf16_t* hid;
    __device__ __forceinline__ void operator()(const Acc& acc, const Unit& u, int wr, int wc, int fr, int fq) const {
        const int row0 = u.pm * BM + wr * 64 + fr;
#pragma unroll
        for (int ai = 0; ai < 2; ++ai)
#pragma unroll
            for (int m = 0; m < 4; ++m) { const int r = row0 + ai * HALF + m * 16;
#pragma unroll
                for (int bj = 0; bj < 2; ++bj) { const f32x4 gt = acc[ai][bj][m][0], up = acc[ai][bj][m][1]; float h[4];
#pragma unroll
                    for (int i = 0; i < 4; ++i) h[i] = gt[i] * sigmoidf_(gt[i]) * up[i];
                    u32x2 w; w.x = cvt_pk_bf16(h[0], h[1]); w.y = cvt_pk_bf16(h[2], h[3]);
                    *(u32x2*)(hid + (size_t)r * DFF + u.pn * 128 + bj * 64 + wc * 16 + 4 * fq) = w; } }
    }
};

struct EpiC1 {
    static constexpr bool PERM = true, HOOK = false; static constexpr int H1 = -1, H2 = -1;
    bf16_t* h1; const float* posb;
    __device__ __forceinline__ void operator()(const Acc& acc, const Unit& u, int wr, int wc, int fr, int fq) const {
        const int row0 = u.pm * BM + wr * 64 + fr;
#pragma unroll
        for (int ai = 0; ai < 2; ++ai)
#pragma unroll
            for (int m = 0; m < 4; ++m) { const int r = row0 + ai * HALF + m * 16;
#pragma unroll
                for (int bj = 0; bj < 2; ++bj) { const int col = bj * HALF + wc * 32 + 8 * fq; const float* pb = posb + u.pn * 256 + col;
                    f32x4 v0 = acc[ai][bj][m][0], v1 = acc[ai][bj][m][1];
#pragma unroll
                    for (int i = 0; i < 4; ++i) { const float a = v0[i] + pb[i], b = v1[i] + pb[4 + i]; v0[i] = a * sigmoidf_(a); v1[i] = b * sigmoidf_(b); }
                    *(u32x4*)(h1 + (size_t)r * 256 + col) = pack8(v0, v1); } }
    }
};
}

template <class Epi, class Sched> __global__ __launch_bounds__(512, 2) void k_gemm(pg8::Gemm g, Epi E) {
    extern __shared__ __attribute__((aligned(16))) unsigned char shm[];
    Sched S; S.init(g.M, g.N, (int)gridDim.x, (int)blockIdx.x);
    pg8::gemm_phase<Epi, Sched>((LAS unsigned char*)shm, g, S, E);
}

__device__ __forceinline__ int colmap(int mode, int n) {
    if (mode == 0) return n;
    if (mode == 1) {
        if (n < 1536) return n;
        if (n < 5632) return n + 4;
        const int j = n - 5632;
        if (j < 4) return 1536 + j;
        if (j < 28) return 5636 + (j - 4);
        return -1;
    }
    const int q = n >> 3, i = n & 7;
    return i < 4 ? 4 * q + i : DFF + 4 * q + (i - 4);
}
__global__ __launch_bounds__(256) void k_cvt(const float* __restrict__ src, int K, int Nsrc, bf16_t* __restrict__ dst, int ldd, int mode) {
    __shared__ float tile[64][65];
    const int n0 = blockIdx.x * 64, k0 = blockIdx.y * 64, t = threadIdx.x, tx = t & 63, ty = t >> 6;
    const int sc = colmap(mode, n0 + tx);
    for (int kk = ty; kk < 64; kk += 4) tile[kk][tx] = sc >= 0 ? src[(size_t)(k0 + kk) * Nsrc + sc] : 0.f;
    __syncthreads();
    for (int c = t; c < 512; c += 256) { const int n = c >> 3, kc = c & 7;
        u32x4 w; w.x = cvt_pk_bf16(tile[kc * 8 + 0][n], tile[kc * 8 + 1][n]); w.y = cvt_pk_bf16(tile[kc * 8 + 2][n], tile[kc * 8 + 3][n]);
        w.z = cvt_pk_bf16(tile[kc * 8 + 4][n], tile[kc * 8 + 5][n]); w.w = cvt_pk_bf16(tile[kc * 8 + 6][n], tile[kc * 8 + 7][n]);
        *(u32x4*)(dst + (size_t)(n0 + n) * ldd + k0 + kc * 8) = w; }
}
__global__ __launch_bounds__(256) void k_posb(const float* __restrict__ pos, const float* __restrict__ w1, float* __restrict__ posb) {
    const int lj = blockIdx.x, hid = threadIdx.x; const float* p = pos + (size_t)lj * 4096; const float* w = w1 + (size_t)lj * 4096 * 256;
    float s = 0.f;
    for (int kk = 0; kk < 4096; ++kk) s = fmaf(p[kk], w[(size_t)kk * 256 + hid], s);
    posb[lj * 256 + hid] = s;
}

__global__ __launch_bounds__(256) void k_rms_first(const float* __restrict__ x, const float* __restrict__ g, bf16_t* __restrict__ h) {
    const int row = blockIdx.x * 4 + (threadIdx.x >> 6), lane = threadIdx.x & 63;
    const f32x4* xr = (const f32x4*)(x + (size_t)row * DM) + lane; const f32x4* gr = (const f32x4*)g + lane;
    f32x4 v[8]; float s = 0.f;
#pragma unroll
    for (int j = 0; j < 8; ++j) { v[j] = xr[64 * j]; s += (v[j][0] * v[j][0] + v[j][1] * v[j][1]) + (v[j][2] * v[j][2] + v[j][3] * v[j][3]); }
    const float rstd = rsqrtf(wave_sum(s) * (1.f / DM) + EPS);
    u32x2* o = (u32x2*)(h + (size_t)row * DM) + lane;
#pragma unroll
    for (int j = 0; j < 8; ++j) { const f32x4 gg = gr[64 * j]; u32x2 w; w.x = cvt_pk_bf16(v[j][0] * rstd * gg[0], v[j][1] * rstd * gg[1]); w.y = cvt_pk_bf16(v[j][2] * rstd * gg[2], v[j][3] * rstd * gg[3]); o[64 * j] = w; }
}
__global__ __launch_bounds__(256) void k_rms_post(const float* xin, const float* __restrict__ y, const float* __restrict__ ga, const float* __restrict__ gb, float* xout, bf16_t* __restrict__ h) {
    const int row = blockIdx.x * 4 + (threadIdx.x >> 6), lane = threadIdx.x & 63;
    const f32x4* xr = (const f32x4*)(xin + (size_t)row * DM) + lane; const f32x4* yr = (const f32x4*)(y + (size_t)row * DM) + lane; const f32x4* gar = (const f32x4*)ga + lane;
    f32x4 v[8]; float s = 0.f;
#pragma unroll
    for (int j = 0; j < 8; ++j) { v[j] = yr[64 * j]; s += (v[j][0] * v[j][0] + v[j][1] * v[j][1]) + (v[j][2] * v[j][2] + v[j][3] * v[j][3]); }
    const float rstd = rsqrtf(wave_sum(s) * (1.f / DM) + EPS);
    float s2 = 0.f; f32x4* xo = (f32x4*)(xout + (size_t)row * DM) + lane;
#pragma unroll
    for (int j = 0; j < 8; ++j) { const f32x4 gg = gar[64 * j], xv = xr[64 * j];
#pragma unroll
        for (int i = 0; i < 4; ++i) v[j][i] = xv[i] + v[j][i] * rstd * gg[i];
        xo[64 * j] = v[j]; s2 += (v[j][0] * v[j][0] + v[j][1] * v[j][1]) + (v[j][2] * v[j][2] + v[j][3] * v[j][3]); }
    if (gb) { const float rstd2 = rsqrtf(wave_sum(s2) * (1.f / DM) + EPS); const f32x4* gbr = (const f32x4*)gb + lane; u32x2* o = (u32x2*)(h + (size_t)row * DM) + lane;
#pragma unroll
        for (int j = 0; j < 8; ++j) { const f32x4 gg = gbr[64 * j]; u32x2 w; w.x = cvt_pk_bf16(v[j][0] * rstd2 * gg[0], v[j][1] * rstd2 * gg[1]); w.y = cvt_pk_bf16(v[j][2] * rstd2 * gg[2], v[j][3] * rstd2 * gg[3]); o[64 * j] = w; } }
}

__global__ __launch_bounds__(256) void k_cumsum(const float* __restrict__ logf, float* __restrict__ cum) {
    __shared__ float part[256];
    const int bh = blockIdx.x, b = bh >> 2, h = bh & 3, t = threadIdx.x;
    float v[16]; float s = 0.f;
#pragma unroll
    for (int i = 0; i < 16; ++i) { s += logf[((size_t)b * SEQ + t * 16 + i) * 4 + h]; v[i] = s; }
    part[t] = s; __syncthreads();
    for (int o = 1; o < 256; o <<= 1) { float a = t >= o ? part[t - o] : 0.f; __syncthreads(); part[t] += a; __syncthreads(); }
    const float base = t ? part[t - 1] : 0.f;
#pragma unroll
    for (int i = 0; i < 16; ++i) cum[(size_t)bh * SEQ + t * 16 + i] = base + v[i];
}

__global__ __launch_bounds__(256) void k_cmp2(const bf16_t* __restrict__ h1, const float* __restrict__ w2  , bf16_t* __restrict__ kvc) {
    const int row = blockIdx.x * 2 + (threadIdx.x >> 7), n = threadIdx.x & 127, panel = row >> 8, j = panel >> 3;
    const bf16_t* hr = h1 + (size_t)row * 256; const float* w = w2 + (size_t)j * 256 * 128 + n;
    float s = 0.f;
    for (int k = 0; k < 256; ++k) s = fmaf(bf2f(hr[k]), w[(size_t)k * 128], s);
    kvc[(size_t)row * 128 + n] = f2bf(s);
}

template <class KF>
__device__ __forceinline__ bool naive_row(const float* qs, int d0, int d1, float scale, int jlo, int jhi, const KF& kf, float* sc, int lane, float& o0, float& o1) {
    float mx = -INFINITY;
#pragma unroll 1
    for (int j = jlo + lane; j < jhi; j += 64) {
        float s = -INFINITY;
        if (kf.valid(j)) { const bf16_t* kr = kf.krow(j); float a = 0.f;
#pragma unroll 4
            for (int d = d0; d < d1; d += 8) { const bf16x8 kv = *(const bf16x8*)(kr + d);
#pragma unroll
                for (int e = 0; e < 8; ++e) a = fmaf(qs[d + e], bf2f((bf16_t)kv[e]), a); }
            s = a * scale + kf.bias(j); }
        sc[j - jlo] = s; mx = fmaxf(mx, s);
    }
    mx = wave_max(mx);
    const bool any = mx > -INFINITY;
    __syncthreads();
    float sum = 0.f;
#pragma unroll 1
    for (int j = jlo + lane; j < jhi; j += 64) { const float s = sc[j - jlo]; const float p = (any && s > -INFINITY) ? __expf(s - mx) : 0.f; sc[j - jlo] = p; sum += p; }
    sum = wave_sum(sum);
    const float inv = any ? 1.0f / sum : 0.f;
    __syncthreads();
#pragma unroll 1
    for (int j = jlo + lane; j < jhi; j += 64) sc[j - jlo] *= inv;
    __syncthreads();
    float a0 = 0.f, a1 = 0.f;
#pragma unroll 1
    for (int j = jlo; j < jhi; j += 8) {
        float p[8]; unsigned vv[8];
#pragma unroll
        for (int e = 0; e < 8; ++e) { const int je = j + e < jhi ? j + e : jhi - 1; p[e] = j + e < jhi ? sc[je - jlo] : 0.f; vv[e] = *(const unsigned*)(kf.vrow(je) + 2 * lane); }
#pragma unroll
        for (int e = 0; e < 8; ++e) { a0 = fmaf(p[e], __uint_as_float(vv[e] << 16), a0); a1 = fmaf(p[e], __uint_as_float(vv[e] & 0xffff0000u), a1); }
    }
    o0 = a0; o1 = a1;
    return any;
}
struct KfFox { const bf16_t* K; const bf16_t* V; const float* cum; int qi; float cq;
    __device__ bool valid(int j) const { return j <= qi; }
    __device__ const bf16_t* krow(int j) const { return K + (size_t)j * HD; }
    __device__ const bf16_t* vrow(int j) const { return V + (size_t)j * HD; }
    __device__ float bias(int j) const { return cq - cum[j]; } };
struct KfAlibi { const bf16_t* K; const bf16_t* V; int qi; float slope; int win; unsigned long long mask; int usemask;
    __device__ bool valid(int j) const { return j <= qi && (qi - j) < win && (!usemask || ((mask >> (j >> 6)) & 1ull)); }
    __device__ const bf16_t* krow(int j) const { return K + (size_t)j * HD; }
    __device__ const bf16_t* vrow(int j) const { return V + (size_t)j * HD; }
    __device__ float bias(int j) const { return -slope * (float)(qi - j); } };
struct KfCmp { const bf16_t* K; const bf16_t* V; int qi; float slope;
    __device__ bool valid(int c) const { return 16 * c + 31 <= qi; }
    __device__ const bf16_t* krow(int c) const { return K + (size_t)c * HD; }
    __device__ const bf16_t* vrow(int c) const { return V + (size_t)c * HD; }
    __device__ float bias(int c) const { return -slope * (float)(qi - (16 * c + 31)); } };

constexpr int NAIVE_LDS = 4 * 4096 * 4 + 4 * 128 * 4 + 4 * 64 * 4 + 64;
__device__ __forceinline__ void naive_load_q(const bf16_t* qrow, float* qs, int lane) { const unsigned vv = *(const unsigned*)(qrow + 2 * lane); qs[2 * lane] = __uint_as_float(vv << 16); qs[2 * lane + 1] = __uint_as_float(vv & 0xffff0000u); }

__global__ __launch_bounds__(256) void k_naive_fox(const bf16_t* __restrict__ qkv, const float* __restrict__ cum, bf16_t* __restrict__ att) {
    extern __shared__ __attribute__((aligned(16))) unsigned char shm[];
    const int w = threadIdx.x >> 6, lane = threadIdx.x & 63; float* sc = (float*)shm + w * 4096; float* qs = (float*)(shm + 4 * 4096 * 4) + w * 128;
    const int bh = blockIdx.x >> 10, b = bh >> 2, h = bh & 3, qi = (blockIdx.x & 1023) * 4 + w;
    const bf16_t* Q = qkv + ((size_t)((SL_FQ + h) * 4 + b) * SEQ) * HD; const bf16_t* K = qkv + ((size_t)((SL_FK + h) * 4 + b) * SEQ) * HD; const bf16_t* V = qkv + ((size_t)((SL_FV + h) * 4 + b) * SEQ) * HD;
    naive_load_q(Q + (size_t)qi * HD, qs, lane); __syncthreads();
    const float* cm = cum + (size_t)bh * SEQ;
    KfFox kf{K, V, cm, qi, cm[qi]}; float o0, o1;
    naive_row(qs, 0, 128, 0.08838834764831845f, 0, (blockIdx.x & 1023) * 4 + 4, kf, sc, lane, o0, o1);
    *(unsigned*)(att + ((size_t)(b * SEQ + qi)) * DM + h * HD + 2 * lane) = cvt_pk_bf16(o0, o1);
}
__global__ __launch_bounds__(256) void k_naive_diff(const bf16_t* __restrict__ qkv, const float* __restrict__ lamv  , const float* __restrict__ subln  , float lam_init, bf16_t* __restrict__ att) {
    extern __shared__ __attribute__((aligned(16))) unsigned char shm[];
    const int w = threadIdx.x >> 6, lane = threadIdx.x & 63; float* sc = (float*)shm + w * 4096; float* qs = (float*)(shm + 4 * 4096 * 4) + w * 128;
    const int bh = blockIdx.x >> 10, b = bh >> 2, h = bh & 3, qi = (blockIdx.x & 1023) * 4 + w;
    const bf16_t* Q = qkv + ((size_t)((SL_DQ + h) * 4 + b) * SEQ) * HD; const bf16_t* K = qkv + ((size_t)((SL_DK + h) * 4 + b) * SEQ) * HD; const bf16_t* V = qkv + ((size_t)((SL_DV + h) * 4 + b) * SEQ) * HD;
    naive_load_q(Q + (size_t)qi * HD, qs, lane); __syncthreads();
    const float l1 = wave_sum(lamv[lane] * lamv[64 + lane]), l2 = wave_sum(lamv[128 + lane] * lamv[192 + lane]);
    const float lam = expf(l1) - expf(l2) + lam_init;
    const float slope = exp2f(-2.0f * (float)(h + 1));
    KfAlibi kf{K, V, qi, slope, 1 << 30, 0ull, 0};
    const int jhi = (blockIdx.x & 1023) * 4 + 4;
    float a0, a1, b0, b1;
    naive_row(qs, 0, 64, 0.125f, 0, jhi, kf, sc, lane, a0, a1);
    __syncthreads();
    naive_row(qs, 64, 128, 0.125f, 0, jhi, kf, sc, lane, b0, b1);
    float o0 = a0 - lam * b0, o1 = a1 - lam * b1;
    const float ss = wave_sum(o0 * o0 + o1 * o1);
    const float r = rsqrtf(ss * (1.f / 128.f) + EPS) * (1.0f - lam_init);
    o0 = o0 * r * subln[2 * lane]; o1 = o1 * r * subln[2 * lane + 1];
    *(unsigned*)(att + ((size_t)(b * SEQ + qi)) * DM + 512 + h * HD + 2 * lane) = cvt_pk_bf16(o0, o1);
}
__global__ __launch_bounds__(256) void k_naive_nsa(const bf16_t* __restrict__ qkv, const bf16_t* __restrict__ kvc, const float* __restrict__ nsag, bf16_t* __restrict__ att, unsigned long long* __restrict__ selm, int do_attn) {
    extern __shared__ __attribute__((aligned(16))) unsigned char shm[];
    const int w = threadIdx.x >> 6, lane = threadIdx.x & 63; float* sc = (float*)shm + w * 4096; float* qs = (float*)(shm + 4 * 4096 * 4) + w * 128;
    float* imph = (float*)(shm + 4 * 4096 * 4 + 4 * 128 * 4); unsigned long long* mk = (unsigned long long*)(shm + 4 * 4096 * 4 + 4 * 128 * 4 + 4 * 64 * 4);
    const int qi = blockIdx.x & 4095, g = (blockIdx.x >> 12) & 1, b = blockIdx.x >> 13, hh = g * 4 + w;
    const bf16_t* Q = qkv + ((size_t)((SL_NQ + hh) * 4 + b) * SEQ) * HD;
    naive_load_q(Q + (size_t)qi * HD, qs, lane); __syncthreads();
    const float slope = exp2f(-(float)(hh + 1));
    const float scale = 0.08838834764831845f;
    const size_t tok = (size_t)b * SEQ + qi;
    const float g0 = nsag[tok * 24 + hh * 3 + 0], g1 = nsag[tok * 24 + hh * 3 + 1], g2 = nsag[tok * 24 + hh * 3 + 2];
    KfCmp kc{kvc + (size_t)(g * 4 + b) * 256 * HD, kvc + (size_t)(8 + g * 4 + b) * 256 * HD, qi, slope};
    float c0, c1;
    naive_row(qs, 0, 128, scale, 0, 255, kc, sc, lane, c0, c1);
    { float s = 0.f;
      for (int c = 4 * lane - 1; c <= 4 * lane + 3; ++c) if (c >= 0 && c < 255) s += sc[c];
      imph[w * 64 + lane] = s; }
    __syncthreads();
    if (w == 0) {
        const float imp = ((imph[lane] + imph[64 + lane]) + imph[128 + lane]) + imph[192 + lane];
        const int cur = qi >> 6; const bool vs = lane <= cur, forced = (lane == 0) || (lane == cur) || (lane == cur - 1);
        const float v = vs ? (forced ? 1e4f : imp) : -1.0f;
        int rank = 0;
        for (int i = 0; i < 64; ++i) { const float vi = __shfl(v, i); rank += (vi > v || (vi == v && i < lane)) ? 1 : 0; }
        const unsigned long long m = __ballot(rank < 16);
        if (lane == 0) { mk[0] = m; selm[((size_t)b * 2 + g) * SEQ + qi] = m; }
    }
    __syncthreads();
    if (!do_attn) return;
    const unsigned long long mask = mk[0];
    KfAlibi ks{qkv + ((size_t)((SL_NKS + g) * 4 + b) * SEQ) * HD, qkv + ((size_t)((SL_NVS + g) * 4 + b) * SEQ) * HD, qi, slope, 1 << 30, mask, 1};
    float s0, s1;
    naive_row(qs, 0, 128, scale, 0, qi + 1, ks, sc, lane, s0, s1);
    __syncthreads();
    KfAlibi kw{qkv + ((size_t)((SL_NKW + g) * 4 + b) * SEQ) * HD, qkv + ((size_t)((SL_NVW + g) * 4 + b) * SEQ) * HD, qi, slope, 512, 0ull, 0};
    const int wlo = qi - 511 > 0 ? qi - 511 : 0;
    float w0, w1;
    naive_row(qs, 0, 128, scale, wlo, qi + 1, kw, sc, lane, w0, w1);
    const float o0 = g0 * c0 + g1 * s0 + g2 * w0, o1 = g0 * c1 + g1 * s1 + g2 * w1;
    *(unsigned*)(att + tok * DM + 1024 + hh * HD + 2 * lane) = cvt_pk_bf16(o0, o1);
}

template <class Epi, class Sched> static void launch_gemm(const pg8::Gemm& g, const Epi& E, int grid, hipStream_t st) {
    static bool attr = false; if (!attr) { (void)hipFuncSetAttribute((const void*)k_gemm<Epi, Sched>, hipFuncAttributeMaxDynamicSharedMemorySize, pg8::STAGE_BYTES); attr = true; }
    hipLaunchKernelGGL((k_gemm<Epi, Sched>), dim3(grid), dim3(512), pg8::STAGE_BYTES, st, g, E);
}
static void launch_cvt(const float* src, int K, int Nsrc, bf16_t* dst, int ldd, int nrows, int mode, hipStream_t st) {
    hipLaunchKernelGGL(k_cvt, dim3(nrows / 64, K / 64), dim3(256), 0, st, src, K, Nsrc, dst, ldd, mode);
}

extern "C" void kernel_launch(void* const* d_in, const int* in_sizes, int n_in, void* d_out, int out_size, void* d_ws, size_t ws_size, hipStream_t stream) {
    static int grid = 0;
    if (grid == 0) {
        if (n_in != 16 || ws_size < WS_END) { fprintf(stderr, "kernel_launch: bad arguments n_in %d ws %zu need %zu\n", n_in, ws_size, (size_t)WS_END); grid = -1; return; }
        int dev = 0, cus = 0; hipGetDevice(&dev); hipDeviceGetAttribute(&cus, hipDeviceAttributeMultiprocessorCount, dev);
        grid = cus > 0 ? cus : 256;
        (void)hipFuncSetAttribute((const void*)k_naive_fox, hipFuncAttributeMaxDynamicSharedMemorySize, NAIVE_LDS);
        (void)hipFuncSetAttribute((const void*)k_naive_diff, hipFuncAttributeMaxDynamicSharedMemorySize, NAIVE_LDS);
        (void)hipFuncSetAttribute((const void*)k_naive_nsa, hipFuncAttributeMaxDynamicSharedMemorySize, NAIVE_LDS);
    }
    if (grid < 0) return;
    const float* x_in = (const float*)d_in[0]; const float* w_in = (const float*)d_in[1]; const float* fbias = (const float*)d_in[2]; const float* dlam = (const float*)d_in[3];
    const float* subln = (const float*)d_in[4]; const float* cpos = (const float*)d_in[5]; const float* cw1 = (const float*)d_in[6]; const float* cw2 = (const float*)d_in[7];
    const float* wbf = (const float*)d_in[8]; const float* wbd = (const float*)d_in[9]; const float* wbn = (const float*)d_in[10]; const float* wgate = (const float*)d_in[11];
    const float* wout = (const float*)d_in[12]; const float* gains = (const float*)d_in[13]; const float* wup = (const float*)d_in[14]; const float* wdn = (const float*)d_in[15];
    unsigned char* ws = (unsigned char*)d_ws; float* xo = (float*)d_out;
    bf16_t* Wall = (bf16_t*)(ws + WS_W); float* posb = (float*)(ws + WS_POSB); bf16_t* HB = (bf16_t*)(ws + WS_HB); bf16_t* QKV = (bf16_t*)(ws + WS_QKV);
    bf16_t* GATES = (bf16_t*)(ws + WS_GATES); bf16_t* HID = (bf16_t*)(ws + WS_HID); bf16_t* ATT = (bf16_t*)(ws + WS_ATT); bf16_t* MRG = (bf16_t*)(ws + WS_MRG);
    float* Y = (float*)(ws + WS_Y); float* LOGF = (float*)(ws + WS_LOGF); float* NSAG = (float*)(ws + WS_NSAG); float* CUM = (float*)(ws + WS_CUM);
    bf16_t* H1 = (bf16_t*)(ws + WS_H1); bf16_t* KVC = (bf16_t*)(ws + WS_KVC); unsigned long long* SELM = (unsigned long long*)(ws + WS_SELM);

    for (int l = 0; l < NLAYER; ++l) {
        bf16_t* W = Wall + (size_t)l * LW_EL;
        launch_cvt(w_in + (size_t)l * DM * IN_COLS, DM, IN_COLS, W + OFF_W1T, DM, 5888, 1, stream);
        launch_cvt(wgate + (size_t)l * DM * 6144, DM, 6144, W + OFF_W1T + (size_t)5888 * DM, DM, 6144, 0, stream);
        launch_cvt(wbf + (size_t)l * 512 * DM, 512, DM, W + OFF_WBT, DM, DM, 0, stream);
        launch_cvt(wbd + (size_t)l * 512 * DM, 512, DM, W + OFF_WBT + 512, DM, DM, 0, stream);
        launch_cvt(wbn + (size_t)l * 1024 * DM, 1024, DM, W + OFF_WBT + 1024, DM, DM, 0, stream);
        launch_cvt(wout + (size_t)l * DM * DM, DM, DM, W + OFF_WOT, DM, DM, 0, stream);
        launch_cvt(wup + (size_t)l * DM * 2 * DFF, DM, 2 * DFF, W + OFF_WUP, DM, 2 * DFF, 2, stream);
        launch_cvt(wdn + (size_t)l * DFF * DM, DFF, DM, W + OFF_WDN, DFF, DM, 0, stream);
        for (int j = 0; j < 2; ++j) launch_cvt(cw1 + ((size_t)l * 2 + j) * 4096 * 256, 4096, 256, W + OFF_WC1 + (size_t)j * 256 * 4096, 4096, 256, 0, stream);
    }
    hipLaunchKernelGGL(k_posb, dim3(NLAYER * 2), dim3(256), 0, stream, cpos, cw1, posb);

    for (int l = 0; l < NLAYER; ++l) {
        const bf16_t* W = Wall + (size_t)l * LW_EL; const float* gl = gains + (size_t)l * 4 * DM;
        const float lam_init = (float)(0.8 - 0.6 * exp(-0.3 * (double)l));
        if (l == 0) hipLaunchKernelGGL(k_rms_first, dim3(T / 4), dim3(256), 0, stream, x_in, gl, HB);
        { pg8::Gemm g{}; g.A = HB; g.Bt = W + OFF_W1T; g.M = T; g.N = N1; g.K = DM; g.lda = DM; g.ldb = DM;
          pg8::Epi1 e{}; e.qkv = QKV; e.logf = LOGF; e.nsag = NSAG; e.gates = GATES; e.fbias = fbias + l * 4;
          launch_gemm<pg8::Epi1, pg8::StaticOrder>(g, e, grid, stream); }
        hipLaunchKernelGGL(k_cumsum, dim3(16), dim3(256), 0, stream, LOGF, CUM);
        { pg8::Gemm g{}; g.A = QKV + (size_t)SL_NKC * 4 * SEQ * HD; g.Bt = W + OFF_WC1; g.M = 4096; g.N = 512; g.K = 4096; g.lda = 2048; g.ldb = 4096;
          pg8::EpiC1 e{}; e.h1 = H1; e.posb = posb + l * 512;
          launch_gemm<pg8::EpiC1, pg8::CmpOrder>(g, e, grid, stream); }
        hipLaunchKernelGGL(k_cmp2, dim3(16 * 256 / 2), dim3(256), 0, stream, H1, cw2 + (size_t)l * 2 * 256 * 128, KVC);
        hipLaunchKernelGGL(k_naive_fox, dim3(16 * 1024), dim3(256), NAIVE_LDS, stream, QKV, CUM, ATT);
        hipLaunchKernelGGL(k_naive_diff, dim3(16 * 1024), dim3(256), NAIVE_LDS, stream, QKV, dlam + l * 256, subln + l * 128, lam_init, ATT);
        hipLaunchKernelGGL(k_naive_nsa, dim3(4 * 2 * 4096), dim3(256), NAIVE_LDS, stream, QKV, KVC, NSAG, ATT, SELM, 1);
        { pg8::Gemm g{}; g.A = ATT; g.Bt = W + OFF_WBT; g.M = T; g.N = DM; g.K = DM; g.lda = DM; g.ldb = DM;
          pg8::Epi2 e{}; e.gates = GATES; e.out = MRG;
          launch_gemm<pg8::Epi2, pg8::StaticOrder>(g, e, grid, stream); }
        { pg8::Gemm g{}; g.A = MRG; g.Bt = W + OFF_WOT; g.M = T; g.N = DM; g.K = DM; g.lda = DM; g.ldb = DM;
          pg8::EpiF32 e{}; e.C = Y; e.ldc = DM;
          launch_gemm<pg8::EpiF32, pg8::StaticOrder>(g, e, grid, stream); }
        hipLaunchKernelGGL(k_rms_post, dim3(T / 4), dim3(256), 0, stream, l == 0 ? x_in : (const float*)xo, (const float*)Y, gl + DM, gl + 2 * DM, xo, HB);
        { pg8::Gemm g{}; g.A = HB; g.Bt = W + OFF_WUP; g.M = T; g.N = 2 * DFF; g.K = DM; g.lda = DM; g.ldb = DM;
          pg8::EpiSwiGLU e{}; e.hid = HID;
          launch_gemm<pg8::EpiSwiGLU, pg8::StaticOrder>(g, e, grid, stream); }
        { pg8::Gemm g{}; g.A = HID; g.Bt = W + OFF_WDN; g.M = T; g.N = DM; g.K = DFF; g.lda = DFF; g.ldb = DFF;
          pg8::EpiF32 e{}; e.C = Y; e.ldc = DM;
          launch_gemm<pg8::EpiF32, pg8::StaticOrder>(g, e, grid, stream); }
        hipLaunchKernelGGL(k_rms_post, dim3(T / 4), dim3(256), 0, stream, (const float*)xo, (const float*)Y, gl + 3 * DM, l + 1 < NLAYER ? gl + 4 * DM : (const float*)nullptr, xo, HB);
    }
}
```

```cpp
#include <hip/hip_runtime.h>
#include <cstdio>
#include <cstdint>
#include <cmath>

#define LAS __attribute__((address_space(3)))
typedef unsigned short bf16_t;
typedef short bf16x8 __attribute__((ext_vector_type(8)));
typedef short s16x4 __attribute__((ext_vector_type(4)));
typedef float f32x4 __attribute__((ext_vector_type(4)));
typedef float f32x16 __attribute__((ext_vector_type(16)));
typedef unsigned u32x4 __attribute__((ext_vector_type(4)));
typedef unsigned u32x2 __attribute__((ext_vector_type(2)));

constexpr int T = 16384, DM = 2048, NBATCH = 4, SEQ = 4096, NLAYER = 4;
constexpr int IN_COLS = 5660, DFF = 5632, HD = 128;
constexpr int N1 = 12032;
constexpr int NSLOT = 44;
constexpr float EPS = 1e-6f;

constexpr int SL_FQ = 0, SL_FK = 4, SL_FV = 8, SL_DQ = 12, SL_DK = 16, SL_DV = 20, SL_NQ = 24, SL_NKC = 32, SL_NVC = 34, SL_NKS = 36, SL_NVS = 38, SL_NKW = 40, SL_NVW = 42;

constexpr size_t al256(size_t x) { return (x + 255) & ~(size_t)255; }
constexpr size_t WS_CTL   = 0;
constexpr size_t CTL_BYTES = 131072;
constexpr size_t CTL_KB = 65536;
constexpr size_t W1T_EL  = (size_t)N1 * DM;
constexpr size_t WBT_EL  = (size_t)DM * DM;
constexpr size_t WOT_EL  = (size_t)DM * DM;
constexpr size_t WUP_EL  = (size_t)2 * DFF * DM;
constexpr size_t WDN_EL  = (size_t)DM * DFF;
constexpr size_t WC1_EL  = (size_t)2 * 256 * 4096;
constexpr size_t WC2_EL  = (size_t)2 * 128 * 256;
constexpr size_t LW_EL   = W1T_EL + WBT_EL + WOT_EL + WUP_EL + WDN_EL + WC1_EL + WC2_EL;
constexpr size_t OFF_W1T = 0, OFF_WBT = OFF_W1T + W1T_EL, OFF_WOT = OFF_WBT + WBT_EL, OFF_WUP = OFF_WOT + WOT_EL, OFF_WDN = OFF_WUP + WUP_EL, OFF_WC1 = OFF_WDN + WDN_EL, OFF_WC2 = OFF_WC1 + WC1_EL;
constexpr size_t WS_W     = WS_CTL + CTL_BYTES;
constexpr size_t WS_POSB  = al256(WS_W + (size_t)NLAYER * LW_EL * 2);
constexpr size_t WS_HB    = al256(WS_POSB + (size_t)NLAYER * 2 * 256 * 4);
constexpr size_t WS_QKV   = al256(WS_HB + (size_t)T * DM * 2);
constexpr size_t QKV_BYTES = (size_t)NSLOT * NBATCH * SEQ * HD * 2;
constexpr size_t WS_GATES = al256(WS_QKV + QKV_BYTES + 65536);
constexpr size_t WS_HID   = WS_QKV;
constexpr size_t WS_ATT   = al256(WS_GATES + (size_t)3 * T * DM * 2);
constexpr size_t WS_MRG   = al256(WS_ATT + (size_t)T * DM * 2);
constexpr size_t WS_Y     = al256(WS_MRG + (size_t)T * DM * 2);
constexpr size_t WS_LOGF  = al256(WS_Y + (size_t)T * DM * 4);
constexpr size_t WS_NSAG  = al256(WS_LOGF + (size_t)T * 4 * 4);
constexpr size_t WS_CUM   = al256(WS_NSAG + (size_t)T * 24 * 4);
constexpr size_t WS_H1    = al256(WS_CUM + (size_t)16 * SEQ * 4);
constexpr size_t WS_KVC   = al256(WS_H1 + (size_t)16 * 256 * 256 * 2);
constexpr size_t WS_SELM  = al256(WS_KVC + (size_t)16 * 256 * 128 * 2);
constexpr size_t WS_RSTD  = al256(WS_SELM + (size_t)NBATCH * 2 * SEQ * 8);
constexpr size_t WS_XR    = al256(WS_RSTD + (size_t)T * 4);
constexpr size_t WS_END   = al256(WS_XR + (size_t)T * DM * 2);
static_assert((size_t)T * DFF * 2 <= (WS_ATT - WS_QKV), "HID overlay must fit in QKV + GATES");

__device__ __forceinline__ float bf2f(bf16_t b) { return __uint_as_float(((unsigned)b) << 16); }
__device__ __forceinline__ bf16_t f2bf(float f) { unsigned u = __float_as_uint(f); u += 0x7FFFu + ((u >> 16) & 1u); return (bf16_t)(u >> 16); }
typedef __bf16 bf16v2_t __attribute__((ext_vector_type(2)));
typedef float f32v2_t __attribute__((ext_vector_type(2)));
__device__ __forceinline__ unsigned cvt_pk_bf16(float lo, float hi) { const f32v2_t v = {lo, hi}; const bf16v2_t b = __builtin_convertvector(v, bf16v2_t); return __builtin_bit_cast(unsigned, b); }
__device__ __forceinline__ float sigmoidf_(float v) { return __builtin_amdgcn_rcpf(1.0f + __expf(-v)); }
#define SWZ_XOR(v, k) __int_as_float(__builtin_amdgcn_ds_swizzle(__float_as_int(v), ((k) << 10) | 0x1f))
__device__ __forceinline__ float wave_sum(float v) {
    v += SWZ_XOR(v, 1); v += SWZ_XOR(v, 2); v += SWZ_XOR(v, 4); v += SWZ_XOR(v, 8); v += SWZ_XOR(v, 16);
    auto rr = __builtin_amdgcn_permlane32_swap(__float_as_uint(v), __float_as_uint(v), false, false); return __uint_as_float(rr[0]) + __uint_as_float(rr[1]);
}
__device__ __forceinline__ float wave_max(float v) {
    v = fmaxf(v, SWZ_XOR(v, 1)); v = fmaxf(v, SWZ_XOR(v, 2)); v = fmaxf(v, SWZ_XOR(v, 4)); v = fmaxf(v, SWZ_XOR(v, 8)); v = fmaxf(v, SWZ_XOR(v, 16));
    auto rr = __builtin_amdgcn_permlane32_swap(__float_as_uint(v), __float_as_uint(v), false, false); return fmaxf(__uint_as_float(rr[0]), __uint_as_float(rr[1]));
}

__device__ __forceinline__ int lane_id_opaque() { int l = (int)__builtin_amdgcn_mbcnt_hi(~0u, __builtin_amdgcn_mbcnt_lo(~0u, 0u)); asm volatile("" : "+v"(l)); return l; }
#define TID_OPAQUE(wv) ((wv) * 64 + lane_id_opaque())

namespace pg8 {
constexpr int BM = 256, BK = 64, HALF = 128, HTB = HALF * BK * 2, STAGE_BYTES = 8 * HTB, NXCD = 8, WGM = 4;
__host__ __device__ __forceinline__ int lds_byte(int r, int c) { const int st = (r >> 4) * 2 + (c >> 5), rr = r & 15, cc = c & 31, ob = rr * 64 + cc * 2; return st * 1024 + (ob ^ (((ob >> 9) & 1) << 5)); }
__host__ __device__ __forceinline__ void stage_rc(int b, int& R, int& C) { const int st = b / 1024, sb = b % 1024, swz = sb ^ (((sb >> 9) & 1) << 5); R = (st >> 1) * 16 + swz / 64; C = (st & 1) * 32 + (swz % 64) / 2; }
__host__ __device__ __forceinline__ int perm32(int rho) { const int n = rho >> 4, i = rho & 15; return 8 * (i >> 2) + 4 * n + (i & 3); }

struct Unit { int pm, pn, ko; };
struct Gemm { const bf16_t* A; const bf16_t* Bt; int M, N, K, lda, ldb, pad; };

struct StaticOrder {
    int nM, nN, nwg, G, c;
    __host__ __device__ void init(int M, int N, int G_, int c_) { nM = M / BM; nN = N / BM; nwg = nM * nN; G = G_; c = c_; }
    __host__ __device__ bool next(int i, Unit& u) const {
        const long L = (long)i * G + c; if (L >= nwg) return false;
        int wgid = (int)L; { const int q = nwg / NXCD, r = nwg % NXCD, xcd = wgid % NXCD, off = wgid / NXCD; wgid = (xcd < r ? xcd * (q + 1) : r * (q + 1) + (xcd - r) * q) + off; }
        const int nig = WGM * nN, gid = wgid / nig, fm = gid * WGM, gsz = (nM - fm) < WGM ? (nM - fm) : WGM;
        u.pm = fm + ((wgid % nig) % gsz); u.pn = (wgid % nig) / gsz; u.ko = 0; return true;
    }
};
struct CmpOrder {
    int G, c;
    __host__ __device__ void init(int, int, int G_, int c_) { G = G_; c = c_; }
    __host__ __device__ bool next(int i, Unit& u) const { const int Lx = i * G + c; if (Lx >= 16) return false; u.pm = Lx; u.pn = Lx >> 3; u.ko = 0; return true; }
};

typedef f32x4 Acc[2][2][4][2];

template <class Epi, class Sched>
__device__ __forceinline__ void gemm_phase(LAS unsigned char* lds, const Gemm g, const Sched& S, const Epi& E, const int wv) {
    int wid_o = wv; asm volatile("" : "+s"(wid_o));
    const int wid = wid_o, tid = wid * 64 + lane_id_opaque(), lane = tid & 63, wr = wid >> 2, wc = wid & 3, fr = lane & 15, fq = lane >> 4;
    const int K = g.K, nt = K / BK;
    unsigned voffA[2], voffB[2];
#pragma unroll
    for (int i = 0; i < 2; ++i) { int R, C; stage_rc(tid * 16 + i * 8192, R, C); const int Rb = Epi::PERM ? ((R & ~31) + perm32(R & 31)) : R;
        voffA[i] = (unsigned)(R * g.lda + C) * 2u; voffB[i] = (unsigned)(Rb * g.ldb + C) * 2u; }
    const size_t kstep = (size_t)(BK * 2);
    const size_t hstepA = (size_t)HALF * g.lda * 2, hstepB = (size_t)HALF * g.ldb * 2;
    const size_t tstepA = 2 * hstepA, tstepB = 2 * hstepB;
    const unsigned ldsw = (unsigned)wid * 1024u;
    const int aoff = lds_byte(wr * 64 + fr, fq * 8), boff = lds_byte(wc * 32 + fr, fq * 8);
#define PG8_SA(b, h) (((b) * 2 + (h)) * HTB)
#define PG8_SB(b, h) ((4 + (b) * 2 + (h)) * HTB)
#define PG8_STAGE(bufoff, gbase, voff) do { _Pragma("unroll") for (int _i = 0; _i < 2; ++_i) \
        __builtin_amdgcn_global_load_lds((const unsigned*)((const char*)(gbase) + (voff)[_i]), (LAS unsigned*)(lds + (bufoff) + ldsw + _i * 8192), 16, 0, 0); } while (0)
#define PG8_LDA(dst, b, h) do { _Pragma("unroll") for (int m = 0; m < 4; ++m) _Pragma("unroll") for (int k = 0; k < 2; ++k) dst[m][k] = *(const LAS bf16x8*)(lds + PG8_SA(b, h) + aoff + m * 2048 + k * 1024); } while (0)
#define PG8_LDB(dst, b, h) do { _Pragma("unroll") for (int n = 0; n < 2; ++n) _Pragma("unroll") for (int k = 0; k < 2; ++k) dst[n][k] = *(const LAS bf16x8*)(lds + PG8_SB(b, h) + boff + n * 2048 + k * 1024); } while (0)
#define PG8_MMA(ai, bj, At, Bt) do { __builtin_amdgcn_s_setprio(1); _Pragma("unroll") for (int m = 0; m < 4; ++m) _Pragma("unroll") for (int n = 0; n < 2; ++n) _Pragma("unroll") for (int k = 0; k < 2; ++k) \
        acc[ai][bj][m][n] = __builtin_amdgcn_mfma_f32_16x16x32_bf16(Bt[n][k], At[m][k], acc[ai][bj][m][n], 0, 0, 0); __builtin_amdgcn_s_setprio(0); } while (0)
#define PG8_WAIT_V(n) asm volatile("s_waitcnt vmcnt(" #n ")" ::: "memory")
#define PG8_WAIT_L(n) asm volatile("s_waitcnt lgkmcnt(" #n ")" ::: "memory")
#define PG8_BAR __builtin_amdgcn_s_barrier()
#define PG8_SCHED __builtin_amdgcn_sched_barrier(0)
    Unit cur, nxt; int ui = 0;
    if (!S.next(0, cur)) return;
    f32x4 acc[2][2][4][2];
#pragma unroll
    for (int a = 0; a < 2; ++a)
#pragma unroll
        for (int b = 0; b < 2; ++b)
#pragma unroll
            for (int m = 0; m < 4; ++m)
#pragma unroll
                for (int n = 0; n < 2; ++n) acc[a][b][m][n] = (f32x4){0.f, 0.f, 0.f, 0.f};
    bf16x8 At[4][2], B0[2][2], B1[2][2];
    const char* cA = (const char*)g.A + (size_t)cur.pm * tstepA + (size_t)cur.ko * 2; const char* cB = (const char*)g.Bt + (size_t)cur.pn * tstepB + (size_t)cur.ko * 2;
    PG8_STAGE(PG8_SB(0, 0), cB, voffB); PG8_STAGE(PG8_SB(0, 1), cB + hstepB, voffB); PG8_STAGE(PG8_SA(0, 0), cA, voffA); PG8_STAGE(PG8_SA(0, 1), cA + hstepA, voffA);
    if (wr == 1) PG8_BAR;
    PG8_WAIT_V(2); PG8_BAR;
    PG8_STAGE(PG8_SB(1, 0), cB + kstep, voffB); PG8_STAGE(PG8_SA(1, 0), cA + kstep, voffA); PG8_STAGE(PG8_SB(1, 1), cB + hstepB + kstep, voffB);
    PG8_WAIT_V(6); PG8_BAR;
    for (;;) {
        const bool has_next = S.next(ui + 1, nxt);
        const char* nA = has_next ? (const char*)g.A + (size_t)nxt.pm * tstepA + (size_t)nxt.ko * 2 : cA; const char* nB = has_next ? (const char*)g.Bt + (size_t)nxt.pn * tstepB + (size_t)nxt.ko * 2 : cB;
        for (int t = 0; t < nt; t += 2) {
            if constexpr (Epi::HOOK) { if (t == Epi::H1 || t == Epi::H2) E.mid(acc, cur, t, wr, wc, fr, fq); }
            const bool last = (t == nt - 2);
            const char* a1 = cA + (size_t)(t + 1) * kstep;
            const char* a2 = last ? nA : cA + (size_t)(t + 2) * kstep; const char* b2 = last ? nB : cB + (size_t)(t + 2) * kstep;
            const char* a3 = a2 + kstep; const char* b3 = b2 + kstep;
            PG8_LDB(B0, 0, 0); PG8_LDB(B1, 0, 1); PG8_SCHED; PG8_LDA(At, 0, 0); PG8_STAGE(PG8_SA(1, 1), a1 + hstepA, voffA);
            PG8_WAIT_V(8); PG8_WAIT_L(0); PG8_BAR; PG8_MMA(0, 0, At, B0); PG8_MMA(0, 1, At, B1); PG8_BAR; PG8_SCHED;
            PG8_LDA(At, 0, 1); PG8_STAGE(PG8_SB(0, 0), b2, voffB); PG8_STAGE(PG8_SB(0, 1), b2 + hstepB, voffB); PG8_STAGE(PG8_SA(0, 0), a2, voffA);
            PG8_WAIT_V(8); PG8_WAIT_L(0); PG8_BAR; PG8_MMA(1, 0, At, B0); PG8_MMA(1, 1, At, B1); PG8_BAR; PG8_SCHED;
            PG8_LDB(B0, 1, 0); PG8_LDB(B1, 1, 1); PG8_SCHED; PG8_LDA(At, 1, 0); PG8_STAGE(PG8_SA(0, 1), a2 + hstepA, voffA);
            PG8_WAIT_V(8); PG8_WAIT_L(0); PG8_BAR; PG8_MMA(0, 0, At, B0); PG8_MMA(0, 1, At, B1); PG8_BAR; PG8_SCHED;
            PG8_LDA(At, 1, 1); PG8_STAGE(PG8_SB(1, 0), b3, voffB); PG8_STAGE(PG8_SB(1, 1), b3 + hstepB, voffB); PG8_STAGE(PG8_SA(1, 0), a3, voffA);
            PG8_WAIT_V(8); PG8_WAIT_L(0); PG8_BAR; PG8_MMA(1, 0, At, B0); PG8_MMA(1, 1, At, B1); PG8_BAR; PG8_SCHED;
        }
        if (wr == 0) PG8_BAR;
        E(acc, cur, wr, wc, fr, fq);
        if (!has_next) break;
#pragma unroll
        for (int a = 0; a < 2; ++a)
#pragma unroll
            for (int b = 0; b < 2; ++b)
#pragma unroll
                for (int m = 0; m < 4; ++m)
#pragma unroll
                    for (int n = 0; n < 2; ++n) acc[a][b][m][n] = (f32x4){0.f, 0.f, 0.f, 0.f};
        cur = nxt; cA = nA; cB = nB; ++ui;
        if (wr == 1) PG8_BAR;
    }
    PG8_WAIT_V(0);
    PG8_BAR;
#undef PG8_SA
#undef PG8_SB
#undef PG8_STAGE
#undef PG8_LDA
#undef PG8_LDB
#undef PG8_MMA
#undef PG8_WAIT_V
#undef PG8_WAIT_L
#undef PG8_BAR
#undef PG8_SCHED
}

__device__ __forceinline__ u32x4 pack8(const f32x4 v0, const f32x4 v1) { u32x4 w; w.x = cvt_pk_bf16(v0[0], v0[1]); w.y = cvt_pk_bf16(v0[2], v0[3]); w.z = cvt_pk_bf16(v1[0], v1[1]); w.w = cvt_pk_bf16(v1[2], v1[3]); return w; }

struct Epi1 {
    static constexpr bool PERM = true, HOOK = false; static constexpr int H1 = -1, H2 = -1;
    bf16_t* qkv; float* logf; float* nsag; bf16_t* gates; const float* fbias; const float* rstd; unsigned* kbound;
    __device__ __forceinline__ void operator()(const Acc& acc, const Unit& u, int wr, int wc, int fr, int fq) const {
        const int row0 = u.pm * BM + wr * 64 + fr;
        if (u.pn < 22) {
#pragma unroll
            for (int ai = 0; ai < 2; ++ai)
#pragma unroll
                for (int m = 0; m < 4; ++m) { const int r = row0 + ai * HALF + m * 16, b = r >> 12, s = r & 4095;
#pragma unroll
                    for (int bj = 0; bj < 2; ++bj) { const int slot = 2 * u.pn + bj;
                        bf16_t* dst = qkv + (((size_t)(slot * 4 + b) * SEQ + s) * HD + wc * 32 + 8 * fq);
                        *(u32x4*)dst = pack8(acc[ai][bj][m][0], acc[ai][bj][m][1]); } }
            if (u.pn == 8 || u.pn == 9 || u.pn == 18 || u.pn == 20) {
                float pmx[2] = {0.f, 0.f};
#pragma unroll
                for (int ai = 0; ai < 2; ++ai)
#pragma unroll
                    for (int m = 0; m < 4; ++m) {
#pragma unroll
                        for (int bj = 0; bj < 2; ++bj) { const f32x4 v0 = acc[ai][bj][m][0], v1 = acc[ai][bj][m][1];
                            const float ss = ((v0[0] * v0[0] + v0[1] * v0[1]) + (v0[2] * v0[2] + v0[3] * v0[3])) + ((v1[0] * v1[0] + v1[1] * v1[1]) + (v1[2] * v1[2] + v1[3] * v1[3]));
                            pmx[bj] = fmaxf(pmx[bj], ss); } }
#pragma unroll
                for (int bj = 0; bj < 2; ++bj) { float v = pmx[bj]; v = fmaxf(v, SWZ_XOR(v, 1)); v = fmaxf(v, SWZ_XOR(v, 2)); v = fmaxf(v, SWZ_XOR(v, 4)); v = fmaxf(v, SWZ_XOR(v, 8));
                    const int kr = u.pn < 10 ? (2 * u.pn + bj) - 16 : (u.pn == 18 ? 16 + bj : 18 + bj);
                    if (fr == 0) atomicMax(kbound + ((kr * 4 + (row0 >> 12)) * 16 + 4 * wc + fq), __float_as_uint(v)); }
            }
        } else if (u.pn == 22) {
            if (wc == 0) {
#pragma unroll
                for (int ai = 0; ai < 2; ++ai)
#pragma unroll
                    for (int m = 0; m < 4; ++m) { const int r = row0 + ai * HALF + m * 16;
#pragma unroll
                        for (int n = 0; n < 2; ++n)
#pragma unroll
                            for (int i = 0; i < 4; ++i) { const int c = 8 * fq + 4 * n + i; const float v = acc[ai][0][m][n][i];
                                if (c < 4) { const float z = v + fbias[c]; logf[(size_t)r * 4 + c] = fminf(z, 0.f) - log1pf(expf(-fabsf(z))); }
                                else if (c < 28) nsag[(size_t)r * 24 + (c - 4)] = 1.0f / (1.0f + expf(-v)); } }
            }
        } else {
            const int pg = u.pn - 23, bidx = pg >> 3, colt = (pg & 7) * 256;
            unsigned char* gq = (unsigned char*)gates;
#pragma unroll
            for (int ai = 0; ai < 2; ++ai)
#pragma unroll
                for (int m = 0; m < 4; ++m) { const int r = row0 + ai * HALF + m * 16;
#pragma unroll
                    for (int bj = 0; bj < 2; ++bj) { const f32x4 v0 = acc[ai][bj][m][0], v1 = acc[ai][bj][m][1]; u32x2 w = {0u, 0u};
#pragma unroll
                        for (int i = 0; i < 4; ++i) {
                            w.x = __builtin_amdgcn_cvt_pk_u8_f32(fmaxf(sigmoidf_(v0[i]) * 255.f, 1.f), i, w.x); w.y = __builtin_amdgcn_cvt_pk_u8_f32(fmaxf(sigmoidf_(v1[i]) * 255.f, 1.f), i, w.y); }
                        *(u32x2*)(gq + (((size_t)bidx * T + r) * DM + colt + bj * HALF + wc * 32 + 8 * fq)) = w; } }
        }
    }
};

struct Epi2 {
    static constexpr bool PERM = true, HOOK = true; static constexpr int H1 = 8, H2 = 16;
    const bf16_t* gates; bf16_t* out;
    __device__ __forceinline__ void mid(Acc& acc, const Unit& u, int t, int wr, int wc, int fr, int fq) const {
        int row0 = u.pm * BM + wr * 64 + fr; asm volatile("" : "+v"(row0));
        const unsigned char* ga = (const unsigned char*)gates + (t == H1 ? (size_t)0 : (size_t)T * DM); const unsigned char* gb = ga + (size_t)T * DM;
        u32x2 av[2][4][2], bv[2][4][2];
#pragma unroll
        for (int ai = 0; ai < 2; ++ai)
#pragma unroll
            for (int m = 0; m < 4; ++m)
#pragma unroll
                for (int bj = 0; bj < 2; ++bj) { const size_t o = (size_t)(row0 + ai * HALF + m * 16) * DM + u.pn * BM + bj * HALF + wc * 32 + 8 * fq;
                    av[ai][m][bj] = *(const u32x2*)(ga + o); bv[ai][m][bj] = *(const u32x2*)(gb + o); }
#pragma unroll
        for (int ai = 0; ai < 2; ++ai)
#pragma unroll
            for (int m = 0; m < 4; ++m)
#pragma unroll
                for (int bj = 0; bj < 2; ++bj)
#pragma unroll
                    for (int e = 0; e < 8; ++e) { const unsigned wa = e < 4 ? av[ai][m][bj].x : av[ai][m][bj].y, wb = e < 4 ? bv[ai][m][bj].x : bv[ai][m][bj].y;
                        const float fa = (float)((wa >> (8 * (e & 3))) & 255u), fb = (float)((wb >> (8 * (e & 3))) & 255u);
                        acc[ai][bj][m][e >> 2][e & 3] *= fa * __builtin_amdgcn_rcpf(fb); }
    }
    __device__ __forceinline__ void operator()(const Acc& acc, const Unit& u, int wr, int wc, int fr, int fq) const {
        const int row0 = u.pm * BM + wr * 64 + fr; const unsigned char* g2 = (const unsigned char*)gates + (size_t)2 * T * DM;
        u32x2 gv[2][4][2];
#pragma unroll
        for (int ai = 0; ai < 2; ++ai)
#pragma unroll
            for (int m = 0; m < 4; ++m)
#pragma unroll
                for (int bj = 0; bj < 2; ++bj) gv[ai][m][bj] = *(const u32x2*)(g2 + (size_t)(row0 + ai * HALF + m * 16) * DM + u.pn * BM + bj * HALF + wc * 32 + 8 * fq);
#pragma unroll
        for (int ai = 0; ai < 2; ++ai)
#pragma unroll
            for (int m = 0; m < 4; ++m) { const int r = row0 + ai * HALF + m * 16;
#pragma unroll
                for (int bj = 0; bj < 2; ++bj) { const size_t o = (size_t)r * DM + u.pn * BM + bj * HALF + wc * 32 + 8 * fq;
                    f32x4 v0 = acc[ai][bj][m][0], v1 = acc[ai][bj][m][1];
#pragma unroll
                    for (int i = 0; i < 4; ++i) { v0[i] *= (float)((gv[ai][m][bj].x >> (8 * i)) & 255u) * (1.f / 255.f); v1[i] *= (float)((gv[ai][m][bj].y >> (8 * i)) & 255u) * (1.f / 255.f); }
                    *(u32x4*)(out + o) = pack8(v0, v1); } }
    }
};

struct BranchOrder {
    StaticOrder base;
    __host__ __device__ void init(int M, int N, int G_, int c_) { base.init(M, N, G_, c_); }
    __host__ __device__ bool next(int i, Unit& u) const { if (!base.next(i >> 2, u)) return false; u.ko = 512 * (i & 3); return true; }
};
struct Epi2b {
    static constexpr bool PERM = true, HOOK = false; static constexpr int H1 = -1, H2 = -1;
    const bf16_t* gates; bf16_t* out;
    __device__ __forceinline__ void operator()(const Acc& acc, const Unit& u, int wr, int wc, int fr, int fq) const {
        const int row0 = u.pm * BM + wr * 64 + fr, sl = u.ko >> 9; const bf16_t* gp = gates + (size_t)(sl < 2 ? sl : 2) * T * DM;
#pragma unroll
        for (int ai = 0; ai < 2; ++ai) {
            bf16x8 gv[4][2], pv[4][2];
#pragma unroll
            for (int m = 0; m < 4; ++m)
#pragma unroll
                for (int bj = 0; bj < 2; ++bj) { const size_t o = (size_t)(row0 + ai * HALF + m * 16) * DM + u.pn * BM + bj * HALF + wc * 32 + 8 * fq;
                    gv[m][bj] = *(const bf16x8*)(gp + o); if (sl) pv[m][bj] = *(const bf16x8*)(out + o); }
#pragma unroll
            for (int m = 0; m < 4; ++m)
#pragma unroll
                for (int bj = 0; bj < 2; ++bj) { const size_t o = (size_t)(row0 + ai * HALF + m * 16) * DM + u.pn * BM + bj * HALF + wc * 32 + 8 * fq;
                    f32x4 v0 = acc[ai][bj][m][0], v1 = acc[ai][bj][m][1];
#pragma unroll
                    for (int i = 0; i < 4; ++i) { v0[i] *= bf2f((bf16_t)gv[m][bj][i]); v1[i] *= bf2f((bf16_t)gv[m][bj][4 + i]); }
                    if (sl) {
#pragma unroll
                        for (int i = 0; i < 4; ++i) { v0[i] += bf2f((bf16_t)pv[m][bj][i]); v1[i] += bf2f((bf16_t)pv[m][bj][4 + i]); } }
                    *(u32x4*)(out + o) = pack8(v0, v1); }
            __builtin_amdgcn_sched_barrier(0);
        }
    }
};

struct EpiF32 {
    static constexpr bool PERM = false, HOOK = false; static constexpr int H1 = -1, H2 = -1;
    float* C; int ldc; int pad;
    __device__ __forceinline__ void operator()(const Acc& acc, const Unit& u, int wr, int wc, int fr, int fq) const {
        const int row0 = u.pm * BM + wr * 64 + fr, col0 = u.pn * BM + wc * 32 + 4 * fq;
#pragma unroll
        for (int ai = 0; ai < 2; ++ai)
#pragma unroll
            for (int m = 0; m < 4; ++m) { float* rowp = C + (size_t)(row0 + ai * HALF + m * 16) * ldc + col0;
#pragma unroll
                for (int bj = 0; bj < 2; ++bj)
#pragma unroll
                    for (int n = 0; n < 2; ++n) *(f32x4*)(rowp + bj * HALF + n * 16) = acc[ai][bj][m][n]; }
    }
};

struct EpiBf16P {
    static constexpr bool PERM = true, HOOK = false; static constexpr int H1 = -1, H2 = -1;
    bf16_t* C; int ldc; int pad;
    __device__ __forceinline__ void operator()(const Acc& acc, const Unit& u, int wr, int wc, int fr, int fq) const {
        const int row0 = u.pm * BM + wr * 64 + fr, col0 = u.pn * BM + wc * 32 + 8 * fq;
#pragma unroll
        for (int ai = 0; ai < 2; ++ai)
#pragma unroll
            for (int m = 0; m < 4; ++m) { bf16_t* rowp = C + (size_t)(row0 + ai * HALF + m * 16) * ldc + col0;
#pragma unroll
                for (int bj = 0; bj < 2; ++bj) *(u32x4*)(rowp + bj * HALF) = pack8(acc[ai][bj][m][0], acc[ai][bj][m][1]); }
    }
};

struct EpiSwiGLU {
    static constexpr bool PERM = true, HOOK = false; static constexpr int H1 = -1, H2 = -1;
    bf16_t* hid; const float* rstd;
    __device__ __forceinline__ void operator()(const Acc& acc, const Unit& u, int wr, int wc, int fr, int fq) const {
        const int row0 = u.pm * BM + wr * 64 + fr;
#pragma unroll
        for (int ai = 0; ai < 2; ++ai)
#pragma unroll
            for (int m = 0; m < 4; ++m) { const int r = row0 + ai * HALF + m * 16;
#pragma unroll
                for (int bj = 0; bj < 2; ++bj) { const f32x4 gt = acc[ai][bj][m][0], up = acc[ai][bj][m][1]; float h[4];
#pragma unroll
                    for (int i = 0; i < 4; ++i) h[i] = gt[i] * sigmoidf_(gt[i]) * up[i];
                    u32x2 w; w.x = cvt_pk_bf16(h[0], h[1]); w.y = cvt_pk_bf16(h[2], h[3]);
                    *(u32x2*)(hid + (size_t)r * DFF + u.pn * 128 + bj * 64 + wc * 16 + 4 * fq) = w; } }
    }
};

struct EpiC1 {
    static constexpr bool PERM = true, HOOK = false; static constexpr int H1 = -1, H2 = -1;
    bf16_t* h1; const float* posb;
    __device__ __forceinline__ void operator()(const Acc& acc, const Unit& u, int wr, int wc, int fr, int fq) const {
        const int row0 = u.pm * BM + wr * 64 + fr;
#pragma unroll
        for (int ai = 0; ai < 2; ++ai)
#pragma unroll
            for (int m = 0; m < 4; ++m) { const int r = row0 + ai * HALF + m * 16;
#pragma unroll
                for (int bj = 0; bj < 2; ++bj) { const int col = bj * HALF + wc * 32 + 8 * fq; const float* pb = posb + u.pn * 256 + col;
                    f32x4 v0 = acc[ai][bj][m][0], v1 = acc[ai][bj][m][1];
#pragma unroll
                    for (int i = 0; i < 4; ++i) { const float a = v0[i] + pb[i], b = v1[i] + pb[4 + i]; v0[i] = a * sigmoidf_(a); v1[i] = b * sigmoidf_(b); }
                    *(u32x4*)(h1 + (size_t)r * 256 + col) = pack8(v0, v1); } }
    }
};
}


__device__ __forceinline__ int colmap(int mode, int n) {
    if (mode == 0) return n;
    if (mode == 1) {
        if (n < 1536) return n;
        if (n < 5632) return n + 4;
        const int j = n - 5632;
        if (j < 4) return 1536 + j;
        if (j < 28) return 5636 + (j - 4);
        return -1;
    }
    const int q = n >> 3, i = n & 7;
    return i < 4 ? 4 * q + i : DFF + 4 * q + (i - 4);
}

namespace att {
constexpr int KT = 16384, VT = 16384, KAT = 1024, STG = KT + VT + KAT;
constexpr int L_X3 = 3 * STG, L_X2 = 2 * STG;
constexpr int LDS_ATT_TOTAL = 147456;
constexpr int L_SLOT = LDS_ATT_TOTAL - 64, L_T0S = LDS_ATT_TOTAL - 96, L_BARW = LDS_ATT_TOTAL - 32;
constexpr float LOG2E = 1.4426950408889634f;
constexpr float NEG_INF = -__builtin_inff();
__device__ __forceinline__ int crow(int i, int hi) { return (i & 3) + 8 * (i >> 2) + 4 * hi; }

struct DmaOff { unsigned k[2], v[2]; };
__device__ __forceinline__ DmaOff dma_offsets(int wv, int lane) {
    DmaOff d;
#pragma unroll
    for (int ii = 0; ii < 2; ++ii) { const int row = 4 * (2 * wv + ii) + (lane >> 4), p = lane & 15;
        d.k[ii] = (unsigned)(row * 128 + ((p ^ (row & 15)) << 3)); d.v[ii] = (unsigned)(row * 128 + ((p ^ ((row & 3) << 2)) << 3)); }
    return d;
}
__device__ __forceinline__ void dma_tile(LAS unsigned char* sbase, const bf16_t* Kg, const bf16_t* Vg, int key0, const DmaOff& d, int wv) {
#pragma unroll
    for (int ii = 0; ii < 2; ++ii) {
        __builtin_amdgcn_global_load_lds((const unsigned*)(Kg + (size_t)key0 * HD + d.k[ii]), (LAS unsigned*)(sbase + (2 * wv + ii) * 1024), 16, 0, 0);
        __builtin_amdgcn_global_load_lds((const unsigned*)(Vg + (size_t)key0 * HD + d.v[ii]), (LAS unsigned*)(sbase + KT + (2 * wv + ii) * 1024), 16, 0, 0); }
}
__device__ __forceinline__ int kaddr(int lane, int c) { return (lane & 31) * 256 + ((c ^ (lane & 15)) << 4); }
__device__ __forceinline__ int vaddr(int lane, int dblk) { const int q = (lane >> 2) & 3;
    return (4 * (lane >> 5) + q) * 256 + ((dblk ^ q) << 6) + (((lane >> 4) & 1) << 5) + (((lane & 3) >> 1) << 4) + ((lane & 1) << 3); }
__device__ __forceinline__ unsigned pack_hilo(float x) { const float h = __uint_as_float(cvt_pk_bf16(x, 0.f) << 16); return cvt_pk_bf16(h, x - h); }
__device__ __forceinline__ bf16x8 make_qaug(float a0, float a1, int hi) {
    u32x4 w = {pack_hilo(a0), pack_hilo(a1), 0u, 0u}; if (hi) w = (u32x4){0u, 0u, 0u, 0u};
    return *reinterpret_cast<bf16x8*>(&w);
}
__device__ __forceinline__ void load_q(bf16x8* qf, const bf16_t* qrow, int hi) {
#pragma unroll
    for (int s = 0; s < 8; ++s) qf[s] = *(const bf16x8*)(qrow + 16 * s + 8 * hi);
}
template <int NS, bool AUG>
__device__ __forceinline__ void qk_tile(f32x16& p0, f32x16& p1, const LAS unsigned char* sb, const int* ka, int kaa, const bf16x8* qf, const bf16x8 qaug) {
#pragma unroll
    for (int i = 0; i < 16; ++i) { p0[i] = 0.f; p1[i] = 0.f; }
    constexpr int NG = NS / 2;
    bf16x8 kf[2][4];
#define QK_LOAD(g, par) do { kf[par][0] = *(const LAS bf16x8*)(sb + ka[2 * (g)]); kf[par][1] = *(const LAS bf16x8*)(sb + ka[2 * (g)] + 8192); \
        kf[par][2] = *(const LAS bf16x8*)(sb + ka[2 * (g) + 1]); kf[par][3] = *(const LAS bf16x8*)(sb + ka[2 * (g) + 1] + 8192); } while (0)
    QK_LOAD(0, 0);
#pragma unroll
    for (int g = 0; g < NG; ++g) {
        if (g + 1 < NG) QK_LOAD(g + 1, (g + 1) & 1);
        p0 = __builtin_amdgcn_mfma_f32_32x32x16_bf16(kf[g & 1][0], qf[2 * g], p0, 0, 0, 0);
        p1 = __builtin_amdgcn_mfma_f32_32x32x16_bf16(kf[g & 1][1], qf[2 * g], p1, 0, 0, 0);
        p0 = __builtin_amdgcn_mfma_f32_32x32x16_bf16(kf[g & 1][2], qf[2 * g + 1], p0, 0, 0, 0);
        p1 = __builtin_amdgcn_mfma_f32_32x32x16_bf16(kf[g & 1][3], qf[2 * g + 1], p1, 0, 0, 0);
        __builtin_amdgcn_sched_barrier(0);
    }
    if (AUG) {
        const bf16x8 a0 = *(const LAS bf16x8*)(sb + KT + VT + kaa), a1 = *(const LAS bf16x8*)(sb + KT + VT + kaa + 512);
        p0 = __builtin_amdgcn_mfma_f32_32x32x16_bf16(a0, qaug, p0, 0, 0, 0);
        p1 = __builtin_amdgcn_mfma_f32_32x32x16_bf16(a1, qaug, p1, 0, 0, 0);
    }
#undef QK_LOAD
}
__device__ __forceinline__ void softmax_step(f32x16& p0, f32x16& p1, float& m, float& l, f32x16* o, const float sc2) {
    float mx = fmaxf(p0[0], p1[0]);
#pragma unroll
    for (int i = 1; i < 16; ++i) mx = fmaxf(mx, fmaxf(p0[i], p1[i]));
    { auto rr = __builtin_amdgcn_permlane32_swap(__float_as_uint(mx), __float_as_uint(mx), false, false); mx = fmaxf(__uint_as_float(rr[0]), __uint_as_float(rr[1])); }
    constexpr float THR2 = 11.0f;
    if (!__all((mx - m) * sc2 <= THR2)) { const float mn = fmaxf(m, mx); const float alpha = __builtin_amdgcn_exp2f((m - mn) * sc2); l *= alpha;
#pragma unroll
        for (int d = 0; d < 4; ++d)
#pragma unroll
            for (int i = 0; i < 16; ++i) o[d][i] *= alpha;
        m = mn; }
    const float nm = -m * sc2;
    float ps = 0.f;
#pragma unroll
    for (int i = 0; i < 16; ++i) { p0[i] = __builtin_amdgcn_exp2f(fmaf(p0[i], sc2, nm)); p1[i] = __builtin_amdgcn_exp2f(fmaf(p1[i], sc2, nm)); ps += p0[i] + p1[i]; }
    l += ps;
}
__device__ __forceinline__ bf16x8 pfrag(const f32x16& p, int s) {
    u32x4 w; w.x = cvt_pk_bf16(p[8 * s + 0], p[8 * s + 1]); w.y = cvt_pk_bf16(p[8 * s + 2], p[8 * s + 3]); w.z = cvt_pk_bf16(p[8 * s + 4], p[8 * s + 5]); w.w = cvt_pk_bf16(p[8 * s + 6], p[8 * s + 7]);
    return *reinterpret_cast<bf16x8*>(&w);
}
__device__ __forceinline__ void pv_tile(f32x16* o, const LAS unsigned char* sb, const int* va, const f32x16& p0, const f32x16& p1) {
    bf16x8 pf[4]; pf[0] = pfrag(p0, 0); pf[1] = pfrag(p0, 1); pf[2] = pfrag(p1, 0); pf[3] = pfrag(p1, 1);
    s16x4 vl[2][4], vh[2][4];
#define PV_LOAD(d, par) do { _Pragma("unroll") for (int ks = 0; ks < 4; ++ks) { const LAS unsigned char* a_ = sb + KT + va[d] + 4096 * ks; \
        vl[par][ks] = __builtin_amdgcn_ds_read_tr16_b64_v4i16((LAS s16x4*)a_); vh[par][ks] = __builtin_amdgcn_ds_read_tr16_b64_v4i16((LAS s16x4*)(a_ + 2048)); } } while (0)
    PV_LOAD(0, 0);
#pragma unroll
    for (int d = 0; d < 4; ++d) {
        if (d + 1 < 4) PV_LOAD(d + 1, (d + 1) & 1);
#pragma unroll
        for (int ks = 0; ks < 4; ++ks) {
            const s16x4 lo = vl[d & 1][ks], hh = vh[d & 1][ks];
            const bf16x8 vf = {lo[0], lo[1], lo[2], lo[3], hh[0], hh[1], hh[2], hh[3]};
            o[d] = __builtin_amdgcn_mfma_f32_32x32x16_bf16(vf, pf[ks], o[d], 0, 0, 0);
        }
        __builtin_amdgcn_sched_barrier(0);
    }
#undef PV_LOAD
}
__device__ __forceinline__ float half_sum(float v) { auto rr = __builtin_amdgcn_permlane32_swap(__float_as_uint(v), __float_as_uint(v), false, false); return __uint_as_float(rr[0]) + __uint_as_float(rr[1]); }

__device__ __forceinline__ int queue_next(unsigned* ctr, LAS int* slot, const int wv) {
    __syncthreads();
    if (TID_OPAQUE(wv) == 0) { unsigned long long ca = (unsigned long long)ctr; asm volatile("" : "+s"(ca));
        *slot = (int)__hip_atomic_fetch_add((unsigned*)ca, 1u, __ATOMIC_RELAXED, __HIP_MEMORY_SCOPE_AGENT); }
    __syncthreads();
    return *slot;
}

template <int NSTG, bool CUM, class KF, class DJF, class BODY>
__device__ __forceinline__ void tile_loop(int NT, LAS unsigned char* lds, const bf16_t* Kg, const bf16_t* Vg, const float* cm, int tid, int wv, const KF& kf, const DJF& djf, const BODY& body) {
    const int lane = tid & 63;
    const DmaOff dof = dma_offsets(wv, lane);
#define TL_ISSUE(i, stg) do { const int i_ = (i) < NT ? (i) : NT - 1; const int k0_ = kf(i_); LAS unsigned char* sb_ = lds + (stg) * STG; dma_tile(sb_, Kg, Vg, k0_, dof, wv); \
        if (CUM) { if (wv == 0) __builtin_amdgcn_global_load_lds((const unsigned*)(cm + k0_ + lane), (LAS unsigned*)(sb_ + KT + VT), 4, 0, 0); } \
        else if (tid < 64) { const float fr_ = (float)tid, dj_ = djf(i_); *(LAS u32x4*)(sb_ + KT + VT + tid * 16) = (u32x4){cvt_pk_bf16(fr_, fr_), cvt_pk_bf16(dj_, dj_), 0u, 0u}; } } while (0)
#define TL_WAIT() do { if (NSTG == 3) asm volatile("s_waitcnt vmcnt(4) lgkmcnt(0)" ::: "memory"); else asm volatile("s_waitcnt vmcnt(0) lgkmcnt(0)" ::: "memory"); \
        __builtin_amdgcn_s_barrier(); asm volatile("" ::: "memory"); } while (0)
    TL_ISSUE(0, 0);
    if (NSTG == 3) TL_ISSUE(1, 1);
    TL_WAIT();
    if (NSTG == 3) {
        for (int t = 0; t < NT; t += 3) {
            TL_ISSUE(t + 2, 2); body(t, lds); TL_WAIT();
            if (t + 1 >= NT) break;
            TL_ISSUE(t + 3, 0); body(t + 1, lds + STG); TL_WAIT();
            if (t + 2 >= NT) break;
            TL_ISSUE(t + 4, 1); body(t + 2, lds + 2 * STG); TL_WAIT();
        }
    } else {
        for (int t = 0; t < NT; t += 2) {
            TL_ISSUE(t + 1, 1); body(t, lds); TL_WAIT();
            if (t + 1 >= NT) break;
            TL_ISSUE(t + 2, 0); body(t + 1, lds + STG); TL_WAIT();
        }
    }
    asm volatile("s_waitcnt vmcnt(0)" ::: "memory"); __builtin_amdgcn_s_barrier(); asm volatile("" ::: "memory");
#undef TL_ISSUE
#undef TL_WAIT
}

__device__ __forceinline__ void fox_item(int bh, int xb, LAS unsigned char* lds, const bf16_t* qkv, const float* cum, bf16_t* attb, const int wv) {
    const int tid = TID_OPAQUE(wv);
    const int wid = wv, lane = tid & 63, r32 = lane & 31, hi = lane >> 5;
    const int b = bh >> 2, h = bh & 3, q0 = xb * 256, qw = q0 + 32 * wid, qi = qw + r32;
    const bf16_t* Qg = qkv + ((size_t)((SL_FQ + h) * 4 + b) * SEQ) * HD; const bf16_t* Kg = qkv + ((size_t)((SL_FK + h) * 4 + b) * SEQ) * HD; const bf16_t* Vg = qkv + ((size_t)((SL_FV + h) * 4 + b) * SEQ) * HD;
    const float* cm = cum + (size_t)bh * SEQ;
    bf16x8 qf[8]; load_q(qf, Qg + (size_t)qi * HD, hi);
    bf16x8 qaug; { u32x4 w = {0u, 0u, 0u, 0u}; qaug = *reinterpret_cast<bf16x8*>(&w); }
    const int NT = 4 * (xb + 1);
    int ka[8], va[4];
#pragma unroll
    for (int s = 0; s < 8; ++s) ka[s] = kaddr(lane, 2 * s + hi);
#pragma unroll
    for (int d = 0; d < 4; ++d) va[d] = vaddr(lane, d);
    f32x16 o[4];
#pragma unroll
    for (int d = 0; d < 4; ++d)
#pragma unroll
        for (int i = 0; i < 16; ++i) o[d][i] = 0.f;
    float m = -1e30f, l = 0.f;
    constexpr float SCN = 0.08838834764831845f, SC2 = SCN * LOG2E, CINV = 1.0f / SCN;
    const float cq0 = cm[q0];
    auto kf = [&](int i) { return 64 * i; };
    auto djf = [&](int) { return 0.f; };
    auto body = [&](int t, LAS unsigned char* sb) {
        const int key0 = 64 * t;
        if (key0 <= qw + 31) {
            f32x16 p0, p1;
            qk_tile<8, false>(p0, p1, sb, ka, 0, qf, qaug);
            const LAS float* cb = (const LAS float*)(sb + KT + VT);
#pragma unroll
            for (int g = 0; g < 4; ++g) {
                const f32x4 c0 = *(const LAS f32x4*)(cb + 8 * g + 4 * hi), c1 = *(const LAS f32x4*)(cb + 32 + 8 * g + 4 * hi);
#pragma unroll
                for (int e = 0; e < 4; ++e) { const int i = 4 * g + e; p0[i] = fmaf(cq0 - c0[e], CINV, p0[i]); p1[i] = fmaf(cq0 - c1[e], CINV, p1[i]); }
            }
            if (key0 + 63 > qw) {
                asm volatile("; masked tile: keep this a real branch (rare path)");
                const int dq = qi - key0 - 4 * hi;
#pragma unroll
                for (int i = 0; i < 16; ++i) { const int c = (i & 3) + 8 * (i >> 2); p0[i] = c > dq ? NEG_INF : p0[i]; p1[i] = c + 32 > dq ? NEG_INF : p1[i]; }
            }
            softmax_step(p0, p1, m, l, o, SC2);
            pv_tile(o, sb, va, p0, p1);
        }
    };
    tile_loop<3, true>(NT, lds, Kg, Vg, cm, tid, wv, kf, djf, body);
    const float inv = 1.0f / half_sum(l);
    bf16_t* orow = attb + ((size_t)(b * SEQ + qi)) * DM + h * HD;
#pragma unroll
    for (int d = 0; d < 4; ++d)
#pragma unroll
        for (int g = 0; g < 4; ++g) { u32x2 w; w.x = cvt_pk_bf16(o[d][4 * g] * inv, o[d][4 * g + 1] * inv); w.y = cvt_pk_bf16(o[d][4 * g + 2] * inv, o[d][4 * g + 3] * inv);
            *(u32x2*)(orow + 32 * d + 8 * g + 4 * hi) = w; }
}

__device__ __forceinline__ void diff_map_step(f32x16* o, float& m, float& l, const LAS unsigned char* sb, const int* ka, int kaa, const int* va, const bf16x8* qf, const bf16x8 qaug,
                                              bool needmask, int dq  ) {
    f32x16 p0, p1;
    qk_tile<4, true>(p0, p1, sb, ka, kaa, qf, qaug);
    if (needmask) {
        asm volatile("; masked tile: keep this a real branch (rare path)");
#pragma unroll
        for (int i = 0; i < 16; ++i) { const int c = (i & 3) + 8 * (i >> 2); p0[i] = c > dq ? NEG_INF : p0[i]; p1[i] = c + 32 > dq ? NEG_INF : p1[i]; } }
    softmax_step(p0, p1, m, l, o, 0.125f * LOG2E);
    pv_tile(o, sb, va, p0, p1);
}
constexpr int L_DX = 0;
__device__ __forceinline__ void diff_item(int bh, int xb, LAS unsigned char* lds, const bf16_t* qkv, const unsigned* kbound, const float* lamv, const float* subln, float lam_init, float oml, bf16_t* attb, const int wv) {
    const int tid = TID_OPAQUE(wv);
    const int wid = wv, lane = tid & 63, r32 = lane & 31, hi = lane >> 5, rw = wid & 3, mp = wid >> 2;
    const int b = bh >> 2, h = bh & 3, q0 = xb * 128, qw = q0 + 32 * rw, qi = qw + r32;
    const bf16_t* Qg = qkv + ((size_t)((SL_DQ + h) * 4 + b) * SEQ) * HD; const bf16_t* Kg = qkv + ((size_t)((SL_DK + h) * 4 + b) * SEQ) * HD; const bf16_t* Vg = qkv + ((size_t)((SL_DV + h) * 4 + b) * SEQ) * HD;
    bf16x8 qf[4];
#pragma unroll
    for (int s = 0; s < 4; ++s) qf[s] = *(const bf16x8*)(Qg + (size_t)qi * HD + 64 * mp + 16 * s + 8 * hi);
    const float a0 = exp2f(-2.0f * (float)(h + 1)) * 8.0f;
    const bf16x8 qaug = make_qaug(a0, 64.0f * a0, hi);
    const int NTall = 2 * (xb + 1), j0 = 2 * xb;
    int ka[4], va[4]; const int kaa = r32 * 16;
#pragma unroll
    for (int s = 0; s < 4; ++s) ka[s] = kaddr(lane, 2 * s + hi + 8 * mp);
#pragma unroll
    for (int d = 0; d < 4; ++d) va[d] = vaddr(lane, d);
    int t0w;
    { float qs = 0.f;
#pragma unroll
      for (int s = 0; s < 4; ++s)
#pragma unroll
          for (int e = 0; e < 8; ++e) { const float v = bf2f((bf16_t)qf[s][e]); qs = fmaf(v, v, qs); }
      qs = wave_max(half_sum(qs));
      float ks = 0.f;
#pragma unroll
      for (int pp = 0; pp < 8; ++pp) ks += __uint_as_float(kbound[(h * 4 + b) * 16 + 8 * mp + pp]);
      const float bound = 2.0f * sqrtf(qs * ks) * 1.02f * (0.125f * LOG2E);
      const float X = (48.0f + bound) / (exp2f(-2.0f * (float)(h + 1)) * LOG2E);
      const float v = ((float)(qw - 63) - X) * (1.0f / 64.0f);
      t0w = v > 0.f ? (int)ceilf(v) : 0; if (t0w > NTall - 1) t0w = NTall - 1; }
    LAS int* t0s = (LAS int*)(lds + L_T0S);
    if (tid == 0) *t0s = NTall;
    __syncthreads();
    if (lane == 0) __hip_atomic_fetch_min(t0s, t0w, __ATOMIC_RELAXED, __HIP_MEMORY_SCOPE_WORKGROUP);
    __syncthreads();
    const int t0 = *t0s, NT = NTall - t0;
    f32x16 o[4];
#pragma unroll
    for (int d = 0; d < 4; ++d)
#pragma unroll
        for (int i = 0; i < 16; ++i) o[d][i] = 0.f;
    float m = -1e30f, l = 0.f;
    auto kf = [&](int i) { return 64 * (i + t0); };
    auto djf = [&](int i) { return (float)(i + t0 - j0); };
    auto body = [&](int ti, LAS unsigned char* sb) {
        const int t = ti + t0, key0 = 64 * t;
        if (key0 <= qw + 31 && t >= t0w) {
            const bool needmask = key0 + 63 > qw; const int dq = qi - key0 - 4 * hi;
            diff_map_step(o, m, l, sb, ka, kaa, va, qf, qaug, needmask, dq);
        }
    };
    tile_loop<3, false>(NT, lds, Kg, Vg, (const float*)nullptr, tid, wv, kf, djf, body);
    const float la = wave_sum(lamv[lane] * lamv[64 + lane]), lb = wave_sum(lamv[128 + lane] * lamv[192 + lane]);
    const float lam = expf(la) - expf(lb) + lam_init;
    LAS float* xw = (LAS float*)(lds + L_DX) + rw * 4096 + lane;
    const float inv = (mp == 0 ? 1.0f : lam) / half_sum(l);
    if (mp == 1) {
#pragma unroll
        for (int d = 0; d < 4; ++d)
#pragma unroll
            for (int i = 0; i < 16; ++i) xw[(d * 16 + i) * 64] = o[d][i] * inv;
    }
    __syncthreads();
    if (mp == 0) {
        float ss = 0.f;
#pragma unroll
        for (int d = 0; d < 4; ++d)
#pragma unroll
            for (int i = 0; i < 16; ++i) { const float v = o[d][i] * inv - xw[(d * 16 + i) * 64]; o[d][i] = v; ss = fmaf(v, v, ss); if (i == 15) __builtin_amdgcn_sched_barrier(0); }
        ss = half_sum(ss);
        const float rn = rsqrtf(ss * (1.f / 128.f) + EPS) * oml;
        bf16_t* orow = attb + ((size_t)(b * SEQ + qi)) * DM + 512 + h * HD;
#pragma unroll
        for (int d = 0; d < 4; ++d)
#pragma unroll
            for (int g = 0; g < 4; ++g) { const f32x4 sg = *(const f32x4*)(subln + 32 * d + 8 * g + 4 * hi);
                u32x2 w; w.x = cvt_pk_bf16(o[d][4 * g] * rn * sg[0], o[d][4 * g + 1] * rn * sg[1]); w.y = cvt_pk_bf16(o[d][4 * g + 2] * rn * sg[2], o[d][4 * g + 3] * rn * sg[3]);
                *(u32x2*)(orow + 32 * d + 8 * g + 4 * hi) = w; if (g == 3) __builtin_amdgcn_sched_barrier(0); }
    }
}

constexpr int L_NS = L_X2 + 1024;
constexpr int L_SM = L_NS + 65536;
constexpr int L_UM = L_SM + 512;
constexpr int L_TL = L_UM + 128;
constexpr int L_SC = L_TL + 64;
constexpr int NSA_END = L_SC + 1024;
constexpr int L_V2 = 0;

__device__ __forceinline__ void softmax_stats(const f32x16& p0, const f32x16& p1, float& m, float& l, const float sc2) {
    float mx = fmaxf(p0[0], p1[0]);
#pragma unroll
    for (int i = 1; i < 16; ++i) mx = fmaxf(mx, fmaxf(p0[i], p1[i]));
    { auto rr = __builtin_amdgcn_permlane32_swap(__float_as_uint(mx), __float_as_uint(mx), false, false); mx = fmaxf(__uint_as_float(rr[0]), __uint_as_float(rr[1])); }
    const float mn = fmaxf(m, mx), nm = -mn * sc2;
    float ps = 0.f;
#pragma unroll
    for (int i = 0; i < 16; ++i) ps += __builtin_amdgcn_exp2f(fmaf(p0[i], sc2, nm)) + __builtin_amdgcn_exp2f(fmaf(p1[i], sc2, nm));
    l = l * __builtin_amdgcn_exp2f((m - mn) * sc2) + ps; m = mn;
}
__device__ __forceinline__ int ctz64(unsigned long long x) { return __builtin_ctzll(x); }

template <class XF, class POST>
__device__ __forceinline__ void nsa_branch(LAS unsigned char* lds, const bf16_t* Kg, const bf16_t* Vg, unsigned long long tiles, unsigned long long wact, int j0,
                                           const bf16x8* qf, const bf16x8 qaug, const int* ka, int kaa, const int* va, int tid, int wv, float gate, f32x16* o, const XF& xf, const POST& post) {
    if (tiles == 0ull) return;
    constexpr float SC2 = 0.08838834764831845f * LOG2E;
    LAS unsigned char* tl = lds + L_TL;
    if (tid == 0) { unsigned long long bits = tiles; int n = 0; while (bits) { tl[n++] = (unsigned char)ctz64(bits); bits &= bits - 1; } }
    const int NT = __builtin_popcountll(tiles);
    __syncthreads();
    float m = -1e30f, l = 0.f;
    auto kf = [&](int i) { return 64 * (int)tl[i]; };
    auto djf = [&](int i) { return (float)((int)tl[i] - j0); };
    auto bodyA = [&](int t, LAS unsigned char* sb) { const int j = (int)__builtin_amdgcn_readfirstlane((int)tl[t]);
        if ((wact >> j) & 1ull) { f32x16 p0, p1; qk_tile<8, true>(p0, p1, sb, ka, kaa, qf, qaug); xf(p0, p1, j); softmax_stats(p0, p1, m, l, SC2); } };
    tile_loop<2, false>(NT, lds, Kg, Vg, (const float*)nullptr, tid, wv, kf, djf, bodyA);
    const float lt = half_sum(l);
    const float scl = lt > 0.f ? 1.0f / lt : 0.f;
    const float nm = -m * SC2;
    auto bodyB = [&](int t, LAS unsigned char* sb) { const int j = (int)__builtin_amdgcn_readfirstlane((int)tl[t]);
        if ((wact >> j) & 1ull) { f32x16 p0, p1; qk_tile<8, true>(p0, p1, sb, ka, kaa, qf, qaug); xf(p0, p1, j);
#pragma unroll
            for (int i = 0; i < 16; ++i) { p0[i] = __builtin_amdgcn_exp2f(fmaf(p0[i], SC2, nm)) * scl; p1[i] = __builtin_amdgcn_exp2f(fmaf(p1[i], SC2, nm)) * scl; }
            post(p0, p1, j);
#pragma unroll
            for (int i = 0; i < 16; ++i) { p0[i] *= gate; p1[i] *= gate; }
            pv_tile(o, sb, va, p0, p1); } };
    tile_loop<2, false>(NT, lds, Kg, Vg, (const float*)nullptr, tid, wv, kf, djf, bodyB);
}

template <class XF, class POST>
__device__ __forceinline__ void nsa_branch_cmp(LAS unsigned char* lds, const bf16_t* Kg, const bf16_t* Vg, unsigned long long tiles, unsigned long long wact, int j0,
                                               const bf16x8* qf, const bf16x8 qaug, const int* ka, int kaa, const int* va, int tid, int wv, float gate, f32x16* o,
                                               LAS float* imprh, LAS float* sclw, const XF& xf, const POST& post) {
    constexpr float SC2 = 0.08838834764831845f * LOG2E;
    LAS unsigned char* tl = lds + L_TL;
    const int NT = __builtin_popcountll(tiles);
    if (tid == 0) { unsigned long long bits = tiles; int n = NT; while (bits) { tl[--n] = (unsigned char)ctz64(bits); bits &= bits - 1; } }
    __syncthreads();
    float m = -1e30f, l = 0.f;
    auto kf = [&](int i) { return 64 * (int)tl[i]; };
    auto djf = [&](int i) { return (float)((int)tl[i] - j0); };
    auto body = [&](int t, LAS unsigned char* sb) { const int j = (int)__builtin_amdgcn_readfirstlane((int)tl[t]);
        if ((wact >> j) & 1ull) { f32x16 p0, p1; qk_tile<8, true>(p0, p1, sb, ka, kaa, qf, qaug); xf(p0, p1, j);
            const float mold = m;
            softmax_step(p0, p1, m, l, o, SC2);
            if (__any(m != mold && mold > -1e29f)) { const float alpha = __builtin_amdgcn_exp2f((mold - m) * SC2);
#pragma unroll 8
                for (int i = 0; i < 32; ++i) imprh[i * 32] *= alpha; }
            post(p0, p1, j);
            pv_tile(o, sb, va, p0, p1); } };
    tile_loop<2, false>(NT, lds, Kg, Vg, (const float*)nullptr, tid, wv, kf, djf, body);
    const float lt = half_sum(l);
    const float scl = lt > 0.f ? 1.0f / lt : 0.f;
    if ((tid & 63) < 32) sclw[tid & 31] = scl;
    const float inv = gate * scl;
#pragma unroll
    for (int d = 0; d < 4; ++d)
#pragma unroll
        for (int i = 0; i < 16; ++i) o[d][i] *= inv;
}
template <class XF>
__device__ __forceinline__ void nsa_branch_online(LAS unsigned char* lds, const bf16_t* Kg, const bf16_t* Vg, unsigned long long tiles, unsigned long long wact, int j0,
                                                  const bf16x8* qf, const bf16x8 qaug, const int* ka, int kaa, const int* va, int tid, int wv, float gate, f32x16* o, const XF& xf) {
    constexpr float SC2 = 0.08838834764831845f * LOG2E;
    LAS unsigned char* tl = lds + L_TL;
    if (tid == 0) { unsigned long long bits = tiles; int n = 0; while (bits) { tl[n++] = (unsigned char)ctz64(bits); bits &= bits - 1; } }
    const int NT = __builtin_popcountll(tiles);
    __syncthreads();
    float m = -1e30f, l = 0.f;
    auto kf = [&](int i) { return 64 * (int)tl[i]; };
    auto djf = [&](int i) { return (float)((int)tl[i] - j0); };
    auto body = [&](int t, LAS unsigned char* sb) { const int j = (int)__builtin_amdgcn_readfirstlane((int)tl[t]);
        if ((wact >> j) & 1ull) { f32x16 p0, p1; qk_tile<8, true>(p0, p1, sb, ka, kaa, qf, qaug); xf(p0, p1, j);
            softmax_step(p0, p1, m, l, o, SC2); pv_tile(o, sb, va, p0, p1); } };
    tile_loop<2, false>(NT, lds, Kg, Vg, (const float*)nullptr, tid, wv, kf, djf, body);
    const float inv = gate / half_sum(l);
#pragma unroll
    for (int d = 0; d < 4; ++d)
#pragma unroll
        for (int i = 0; i < 16; ++i) o[d][i] *= inv;
}
__device__ __forceinline__ void park_store(LAS unsigned* slab, int lane, const f32x16* o) {
#pragma unroll
    for (int d = 0; d < 4; ++d)
#pragma unroll
        for (int i = 0; i < 8; ++i) slab[(d * 8 + i) * 64 + lane] = cvt_pk_bf16(o[d][2 * i], o[d][2 * i + 1]);
}
__device__ __forceinline__ void park_add(const LAS unsigned* slab, int lane, f32x16* o) {
#pragma unroll
    for (int d = 0; d < 4; ++d)
#pragma unroll
        for (int i = 0; i < 8; ++i) { const unsigned w = slab[(d * 8 + i) * 64 + lane]; o[d][2 * i] += __uint_as_float(w << 16); o[d][2 * i + 1] += __uint_as_float(w & 0xffff0000u); }
}

__device__ __forceinline__ void nsa_item(int bg, int xq, LAS unsigned char* lds, const bf16_t* qkv, const bf16_t* kvc, const float* nsag, const unsigned* kbound, bf16_t* attb, const int wv) {
    const int tid = TID_OPAQUE(wv);
    const int wid = wv, lane = tid & 63, r32 = lane & 31, hi = lane >> 5, hw = (wid >> 1) ^ ((wid >> 2) & 1), sub = wid & 1;
    const int b = bg >> 1, g = bg & 1, hh = g * 4 + hw, q0 = xq * 64, qw = q0 + 32 * sub, qi = qw + r32, cur = xq;
    const bf16_t* Qg = qkv + ((size_t)((SL_NQ + hh) * 4 + b) * SEQ) * HD;
    bf16x8 qf[8]; load_q(qf, Qg + (size_t)qi * HD, hi);
    const size_t tok = (size_t)b * SEQ + qi;
    const float g0 = nsag[tok * 24 + hh * 3 + 0], g1 = nsag[tok * 24 + hh * 3 + 1], g2 = nsag[tok * 24 + hh * 3 + 2];
    const float a0 = exp2f(-(float)(hh + 1)) * 11.313708498984761f;
    const bf16x8 qaug = make_qaug(a0, 64.0f * a0, hi), qaugc = make_qaug(16.0f * a0, 1024.0f * a0, hi);
    int ka[8], va[4]; const int kaa = r32 * 16;
#pragma unroll
    for (int s = 0; s < 8; ++s) ka[s] = kaddr(lane, 2 * s + hi);
#pragma unroll
    for (int d = 0; d < 4; ++d) va[d] = vaddr(lane, d);
    f32x16 o[4];
#pragma unroll
    for (int d = 0; d < 4; ++d)
#pragma unroll
        for (int i = 0; i < 16; ++i) o[d][i] = 0.f;
    LAS float* impw = (LAS float*)(lds + L_NS) + wid * 2048;
    LAS unsigned* selm = (LAS unsigned*)(lds + L_SM);
    LAS unsigned* um = (LAS unsigned*)(lds + L_UM);
#pragma unroll
    for (int i = 0; i < 32; ++i) impw[i * 64 + lane] = 0.f;
    LAS int* t0m = (LAS int*)(lds + L_T0S);
    if (wid == 0) { selm[lane] = 0u; selm[64 + lane] = 0u; if (lane < 18) um[lane] = 0u; if (lane < 2) t0m[lane] = 64; }
    __syncthreads();
    int t0sel, t0win;
    { float qs = 0.f;
#pragma unroll
      for (int s = 0; s < 8; ++s)
#pragma unroll
          for (int e = 0; e < 8; ++e) { const float v = bf2f((bf16_t)qf[s][e]); qs = fmaf(v, v, qs); }
      qs = wave_max(half_sum(qs));
      const unsigned* kb = kbound + 1024 + (g * 4 + b) * 16;
      float kss = 0.f, ksw = 0.f;
#pragma unroll
      for (int pp = 0; pp < 16; ++pp) { kss += __uint_as_float(kb[pp]); ksw += __uint_as_float(kb[128 + pp]); }
      const float c2 = 2.0f * 1.02f * (0.08838834764831845f * LOG2E), isl = 1.0f / (exp2f(-(float)(hh + 1)) * LOG2E);
      const float vs = ((float)(qw - 63) - (48.0f + c2 * sqrtf(qs * kss)) * isl) * (1.0f / 64.0f), vw = ((float)(qw - 63) - (48.0f + c2 * sqrtf(qs * ksw)) * isl) * (1.0f / 64.0f);
      int ts = vs > 0.f ? (int)ceilf(vs) : 0, tw = vw > 0.f ? (int)ceilf(vw) : 0;
      ts = ts > cur ? cur : ts; tw = tw > cur ? cur : tw;
      t0sel = __builtin_amdgcn_readfirstlane(ts); t0win = __builtin_amdgcn_readfirstlane(tw);
      if (lane == 0) { __hip_atomic_fetch_min(t0m, t0sel, __ATOMIC_RELAXED, __HIP_MEMORY_SCOPE_WORKGROUP); __hip_atomic_fetch_min(t0m + 1, t0win, __ATOMIC_RELAXED, __HIP_MEMORY_SCOPE_WORKGROUP); } }
    {
        const int cq = qi >= 31 ? (qi - 31) >> 4 : -1;
        const int cmax_w = (qw + 31 - 31) >> 4;
        const int ntc = ((4 * xq + 2) >> 6) + 1;
        const unsigned long long tiles = (1ull << ntc) - 1ull;
        const unsigned long long wact = (1ull << ((cmax_w >> 6) + 1)) - 1ull;
        const int cqmin = qw >= 31 ? (qw - 31) >> 4 : -1;
        auto xf = [&](f32x16& p0, f32x16& p1, int j) {
            if (64 * j + 63 > cqmin) {
                asm volatile("; masked tile: keep this a real branch (rare path)");
                const int c0 = 64 * j + 4 * hi;
#pragma unroll
                for (int i = 0; i < 16; ++i) { const int c = c0 + (i & 3) + 8 * (i >> 2); p0[i] = c > cq ? NEG_INF : p0[i]; p1[i] = c + 32 > cq ? NEG_INF : p1[i]; } }
        };
        auto post = [&](const f32x16& p0, const f32x16& p1, int j) {
            LAS float* cell = impw + (16 * j + hi) * 32 + r32;
            const int paddr = (lane ^ 32) << 2;
            float X[4][2];
#pragma unroll
            for (int gq = 0; gq < 4; ++gq) { X[gq][0] = __int_as_float(__builtin_amdgcn_ds_bpermute(paddr, __float_as_int(p0[4 * gq + 3]))); X[gq][1] = __int_as_float(__builtin_amdgcn_ds_bpermute(paddr, __float_as_int(p1[4 * gq + 3]))); }
#pragma unroll
            for (int kh = 0; kh < 2; ++kh)
#pragma unroll
                for (int gq = 0; gq < 4; ++gq) {
                    const float sum4 = kh ? ((p1[4 * gq] + p1[4 * gq + 1]) + p1[4 * gq + 2]) + p1[4 * gq + 3] : ((p0[4 * gq] + p0[4 * gq + 1]) + p0[4 * gq + 2]) + p0[4 * gq + 3];
                    const float prevlo = gq ? X[gq - 1][kh] : (kh ? X[3][0] : 0.f);
                    cell[(8 * kh + 2 * gq) * 32] = sum4 + (hi ? X[gq][kh] : prevlo);
                }
            if (hi && 16 * j + 16 < 64) cell[15 * 32] += p1[15];
        };
        nsa_branch_cmp(lds, kvc + (size_t)(g * 4 + b) * 256 * HD, kvc + (size_t)(8 + g * 4 + b) * 256 * HD, tiles, wact, ntc - 1, qf, qaugc, ka, kaa, va, tid, wv, g0, o,
                       impw + 1024 * hi + r32, (LAS float*)(lds + L_SC) + wid * 32, xf, post);
    }
    __syncthreads();
    {
        const int q = tid >> 3, jg = tid & 7;
        const LAS float* ib = (const LAS float*)(lds + L_NS) + (q >> 5) * 2048 + jg * 256 + (q & 31);
        LAS float* v2 = (LAS float*)(lds + L_V2) + q * 64;
        const LAS float* scq = (const LAS float*)(lds + L_SC) + (q >> 5) * 32 + (q & 31);
        const float sc0 = scq[0], sc1 = scq[64], sc2 = scq[128], sc3 = scq[192];
        unsigned kj[8];
        LAS unsigned* v2u = (LAS unsigned*)v2;
#pragma unroll
        for (int e = 0; e < 8; ++e) { const int j = jg * 8 + e;
            const float imp = ((ib[32 * e] * sc0 + ib[4096 + 32 * e] * sc1) + ib[8192 + 32 * e] * sc2) + ib[12288 + 32 * e] * sc3;
            const bool vs = j <= cur, forced = (j == 0) || (j == cur) || (j == cur - 1);
            kj[e] = vs ? ((__float_as_uint(forced ? 1e4f : imp) & ~63u) | (unsigned)(63 - j)) : 0u; v2u[jg * 8 + e] = kj[e]; }
        __syncthreads();
        int rank[8];
#pragma unroll
        for (int e = 0; e < 8; ++e) rank[e] = 0;
        for (int i = 0; i < 64; ++i) { const unsigned ki = v2u[i];
#pragma unroll
            for (int e = 0; e < 8; ++e) rank[e] += ki > kj[e] ? 1 : 0; }
        unsigned bits = 0u;
#pragma unroll
        for (int e = 0; e < 8; ++e) bits |= (rank[e] < 16 && jg * 8 + e <= cur) ? (1u << e) : 0u;
        bits <<= 8 * (jg & 3);
        __hip_atomic_fetch_or(selm + q * 2 + (jg >> 2), bits, __ATOMIC_RELAXED, __HIP_MEMORY_SCOPE_WORKGROUP);
        __hip_atomic_fetch_or(um + (jg >> 2), bits, __ATOMIC_RELAXED, __HIP_MEMORY_SCOPE_WORKGROUP);
        __hip_atomic_fetch_or(um + 2 + 2 * ((q >> 5) + 0) + (jg >> 2), bits, __ATOMIC_RELAXED, __HIP_MEMORY_SCOPE_WORKGROUP);
        __syncthreads();
    }
    const unsigned sm0 = selm[2 * (qi - q0)], sm1 = selm[2 * (qi - q0) + 1];
    const unsigned long long mysel = ((unsigned long long)sm1 << 32) | sm0;
    const unsigned long long utiles = ((unsigned long long)(unsigned)__builtin_amdgcn_readfirstlane((int)um[1]) << 32) | (unsigned)__builtin_amdgcn_readfirstlane((int)um[0]);
    const unsigned long long wtiles = ((unsigned long long)(unsigned)__builtin_amdgcn_readfirstlane((int)um[2 + 2 * sub + 1]) << 32) | (unsigned)__builtin_amdgcn_readfirstlane((int)um[2 + 2 * sub]);
    __syncthreads();
    {
        auto xf = [&](f32x16& p0, f32x16& p1, int j) {
            const bool mine = (mysel >> j) & 1ull; const int dq = qi - 64 * j - 4 * hi;
            if (j == cur || !__all(mine)) {
                asm volatile("; masked tile: keep this a real branch (rare path)");
#pragma unroll
                for (int i = 0; i < 16; ++i) { const int c = (i & 3) + 8 * (i >> 2); p0[i] = (!mine || c > dq) ? NEG_INF : p0[i]; p1[i] = (!mine || c + 32 > dq) ? NEG_INF : p1[i]; } }
        };
        LAS unsigned* slab = (LAS unsigned*)(lds + L_NS) + wid * 2048;
        park_store(slab, lane, o);
#pragma unroll
        for (int d = 0; d < 4; ++d)
#pragma unroll
            for (int i = 0; i < 16; ++i) o[d][i] = 0.f;
        const int t0a = __builtin_amdgcn_readfirstlane(t0m[0]);
        nsa_branch_online(lds, qkv + ((size_t)((SL_NKS + g) * 4 + b) * SEQ) * HD, qkv + ((size_t)((SL_NVS + g) * 4 + b) * SEQ) * HD, utiles & (~0ull << t0a), wtiles & (~0ull << t0sel), cur, qf, qaug, ka, kaa, va, tid, wv, g1, o, xf);
        park_add(slab, lane, o); park_store(slab, lane, o);
#pragma unroll
        for (int d = 0; d < 4; ++d)
#pragma unroll
            for (int i = 0; i < 16; ++i) o[d][i] = 0.f;
    }
    {
        const int jlo = cur - 8 > 0 ? cur - 8 : 0;
        const unsigned long long tiles = (cur == 63 ? ~0ull : ((1ull << (cur + 1)) - 1ull)) & ~((1ull << jlo) - 1ull);
        auto xf = [&](f32x16& p0, f32x16& p1, int j) {
            const int dq = qi - 64 * j - 4 * hi;
            if (j == cur || j == cur - 8) {
                asm volatile("; masked tile: keep this a real branch (rare path)");
#pragma unroll
                for (int i = 0; i < 16; ++i) { const int c = (i & 3) + 8 * (i >> 2); p0[i] = (unsigned)(dq - c) >= 512u ? NEG_INF : p0[i]; p1[i] = (unsigned)(dq - c - 32) >= 512u ? NEG_INF : p1[i]; } }
        };
        const int t0a = __builtin_amdgcn_readfirstlane(t0m[1]);
        nsa_branch_online(lds, qkv + ((size_t)((SL_NKW + g) * 4 + b) * SEQ) * HD, qkv + ((size_t)((SL_NVW + g) * 4 + b) * SEQ) * HD, tiles & (~0ull << t0a), tiles & (~0ull << t0win), cur, qf, qaug, ka, kaa, va, tid, wv, g2, o, xf);
        park_add((const LAS unsigned*)(lds + L_NS) + wid * 2048, lane, o);
    }
    bf16_t* orow = attb + tok * DM + 1024 + hh * HD;
#pragma unroll
    for (int d = 0; d < 4; ++d)
#pragma unroll
        for (int gq = 0; gq < 4; ++gq) { u32x2 w; w.x = cvt_pk_bf16(o[d][4 * gq], o[d][4 * gq + 1]); w.y = cvt_pk_bf16(o[d][4 * gq + 2], o[d][4 * gq + 3]);
            *(u32x2*)(orow + 32 * d + 8 * gq + 4 * hi) = w; }
}
}

#define XB_TMO      128
#define XB_XCNT(j)  (256  + 64 * (j))
#define XB_XSUB(j)  (1280 + 64 * (j))
#define XB_XGEN(j)  (2304 + 64 * (j))
#define XB_TOP      3328
#define XB_TOPGEN   3392
#define XCD_BAR_WORDS 3456
#define XB_SPIN_CAP (1u << 22)

__device__ __forceinline__ unsigned xb_ld(unsigned* p)              { return __hip_atomic_load(p, __ATOMIC_RELAXED, __HIP_MEMORY_SCOPE_AGENT); }
__device__ __forceinline__ unsigned xb_add(unsigned* p, unsigned v) { return __hip_atomic_fetch_add(p, v, __ATOMIC_RELAXED, __HIP_MEMORY_SCOPE_AGENT); }
__device__ __forceinline__ unsigned xb_xcc_id() { return (unsigned)__builtin_amdgcn_s_getreg((3 << 11) | 20) & 0xFu; }
#define XB_SPIN(cond, bar) do { unsigned _sp = 0; while (cond) { __builtin_amdgcn_s_sleep(1); \
    if ((++_sp & 255u) == 0u) { if (xb_ld(&(bar)[XB_TMO])) break; if (_sp > XB_SPIN_CAP) { atomicAdd(&(bar)[XB_TMO], 1u); break; } } } } while (0)

struct XcdBarrier { unsigned* bar; volatile LAS unsigned* st; };

__device__ __forceinline__ XcdBarrier xcd_barrier_post(unsigned* bar, volatile LAS unsigned* st, const int wv) {
    XcdBarrier b; b.bar = bar; b.st = st;
    if (TID_OPAQUE(wv) == 0) { const unsigned x = xb_xcc_id(); st[2] = x; (void)xb_add(&bar[XB_XCNT(x)], 1u); }
    return b;
}
__device__ __forceinline__ void xcd_barrier_complete(unsigned* bar, unsigned x, unsigned& nloc, unsigned& nx) {
    const unsigned G = gridDim.x * gridDim.y * gridDim.z;
    unsigned sum, cnt, mine, sp = 0u;
    for (;;) {
        sum = 0u; cnt = 0u; mine = 0u;
#pragma unroll
        for (unsigned j = 0; j < 16; ++j) { const unsigned c = xb_ld(&bar[XB_XCNT(j)]); sum += c; cnt += (c > 0u) ? 1u : 0u; mine = (j == x) ? c : mine; }
        if (sum == G) break;
        __builtin_amdgcn_s_sleep(1);
        if ((++sp & 255u) == 0u) { if (xb_ld(&bar[XB_TMO])) break; if (sp > XB_SPIN_CAP) { atomicAdd(&bar[XB_TMO], 1u); break; } }
    }
    nloc = mine > 0u ? mine : 1u; nx = cnt > 0u ? cnt : 1u;
}
__device__ __forceinline__ void xcd_barrier(const XcdBarrier& b, const int wv) {
    asm volatile("s_waitcnt vmcnt(0)" ::: "memory");
    __syncthreads();
    if (TID_OPAQUE(wv) == 0) {
        unsigned* bar = b.bar;
        __builtin_amdgcn_s_waitcnt(0);
        unsigned nloc = b.st[0], nx = b.st[1]; const unsigned bx = b.st[2];
        if (nloc == 0u) { xcd_barrier_complete(bar, bx, nloc, nx); b.st[0] = nloc; b.st[1] = nx; }
        const unsigned old = xb_add(&bar[XB_XSUB(bx)], 1u);
        const unsigned gen = old / nloc;
        if (old + 1u == (gen + 1u) * nloc) {
            __builtin_amdgcn_fence(__ATOMIC_RELEASE, "agent");
            asm volatile("s_waitcnt vmcnt(0)" ::: "memory");
            const unsigned og = xb_add(&bar[XB_TOP], 1u);
            const unsigned tg = og / nx;
            if (og + 1u == (tg + 1u) * nx) xb_add(&bar[XB_TOPGEN], 1u);
            else XB_SPIN(xb_ld(&bar[XB_TOPGEN]) == tg, bar);
            __builtin_amdgcn_fence(__ATOMIC_ACQUIRE, "agent");
            xb_add(&bar[XB_XGEN(bx)], 1u);
            asm volatile("s_waitcnt vmcnt(0)" ::: "memory");
        } else {
            XB_SPIN(xb_ld(&bar[XB_XGEN(bx)]) == gen, bar);
            __builtin_amdgcn_fence(__ATOMIC_ACQUIRE, "agent");
            asm volatile("s_waitcnt vmcnt(0)" ::: "memory");
        }
    }
    __syncthreads();
}

struct Params {
    const float* x_in; const float* w_in; const float* fbias; const float* dlam; const float* subln; const float* cpos; const float* cw1; const float* cw2;
    const float* wbf; const float* wbd; const float* wbn; const float* wgate; const float* wout; const float* gains; const float* wup; const float* wdn;
    float* xo; unsigned char* ws;
};
constexpr int LDS_GEMM = pg8::STAGE_BYTES;
constexpr int LDS_BARW = att::L_BARW;
constexpr int LDS_TOTAL = att::LDS_ATT_TOTAL;
static_assert(att::NSA_END <= att::L_T0S && att::L_X3 + 1024 <= att::L_T0S && LDS_GEMM <= att::L_T0S && att::L_DX + 65536 <= att::L_T0S, "LDS map");

typedef const __attribute__((address_space(4))) Params* KParams;
struct CvtJob { const float* src; bf16_t* dst; const float* gain; int K, Nsrc, ldd, nrows, mode, pad; };
__device__ __forceinline__ CvtJob cvt_job(KParams p, int l, int j) {
    bf16_t* W = (bf16_t*)(p->ws + WS_W) + (size_t)l * LW_EL; CvtJob J{};
    switch (j) {
        case 0: J.src = p->w_in + (size_t)l * DM * IN_COLS; J.dst = W + OFF_W1T; J.K = DM; J.Nsrc = IN_COLS; J.ldd = DM; J.nrows = 5888; J.mode = 1; J.gain = p->gains + (size_t)(l * 4 + 0) * DM; break;
        case 1: J.src = p->wgate + (size_t)l * DM * 6144; J.dst = W + OFF_W1T + (size_t)5888 * DM; J.K = DM; J.Nsrc = 6144; J.ldd = DM; J.nrows = 6144; J.mode = 0; J.gain = p->gains + (size_t)(l * 4 + 0) * DM; break;
        case 2: J.src = p->wbf + (size_t)l * 512 * DM; J.dst = W + OFF_WBT; J.K = 512; J.Nsrc = DM; J.ldd = DM; J.nrows = DM; J.mode = 0; break;
        case 3: J.src = p->wbd + (size_t)l * 512 * DM; J.dst = W + OFF_WBT + 512; J.K = 512; J.Nsrc = DM; J.ldd = DM; J.nrows = DM; J.mode = 0; break;
        case 4: J.src = p->wbn + (size_t)l * 1024 * DM; J.dst = W + OFF_WBT + 1024; J.K = 1024; J.Nsrc = DM; J.ldd = DM; J.nrows = DM; J.mode = 0; break;
        case 5: J.src = p->wout + (size_t)l * DM * DM; J.dst = W + OFF_WOT; J.K = DM; J.Nsrc = DM; J.ldd = DM; J.nrows = DM; J.mode = 0; break;
        case 6: J.src = p->wup + (size_t)l * DM * 2 * DFF; J.dst = W + OFF_WUP; J.K = DM; J.Nsrc = 2 * DFF; J.ldd = DM; J.nrows = 2 * DFF; J.mode = 2; J.gain = p->gains + (size_t)(l * 4 + 2) * DM; break;
        case 7: J.src = p->wdn + (size_t)l * DFF * DM; J.dst = W + OFF_WDN; J.K = DFF; J.Nsrc = DM; J.ldd = DFF; J.nrows = DM; J.mode = 0; break;
        case 8: J.src = p->cw1 + ((size_t)l * 2 + 0) * 4096 * 256; J.dst = W + OFF_WC1; J.K = 4096; J.Nsrc = 256; J.ldd = 4096; J.nrows = 256; J.mode = 0; break;
        case 10: J.src = p->cw2 + ((size_t)l * 2 + 0) * 256 * 128; J.dst = W + OFF_WC2; J.K = 256; J.Nsrc = 128; J.ldd = 256; J.nrows = 128; J.mode = 0; break;
        case 11: J.src = p->cw2 + ((size_t)l * 2 + 1) * 256 * 128; J.dst = W + OFF_WC2 + (size_t)128 * 256; J.K = 256; J.Nsrc = 128; J.ldd = 256; J.nrows = 128; J.mode = 0; break;
        default: J.src = p->cw1 + ((size_t)l * 2 + 1) * 4096 * 256; J.dst = W + OFF_WC1 + (size_t)256 * 4096; J.K = 4096; J.Nsrc = 256; J.ldd = 4096; J.nrows = 256; J.mode = 0; break;
    }
    return J;
}
__device__ __forceinline__ void cvt_tile(const CvtJob& J, int tile, const int wv) {
    const int t = TID_OPAQUE(wv), kb = t & 7, n4 = t >> 3;
    const int nbn = (J.nrows + 255) >> 8, n0 = (tile % nbn) * 256 + 4 * n4, k0 = (tile / nbn) * 64 + 8 * kb;
    if (n0 >= J.nrows) return;
    const int sc = colmap(J.mode, n0);
    f32x4 v[8];
#pragma unroll
    for (int jj = 0; jj < 8; ++jj) v[jj] = sc >= 0 ? __builtin_nontemporal_load((const f32x4*)(J.src + (size_t)(k0 + jj) * J.Nsrc + sc)) : (f32x4){0.f, 0.f, 0.f, 0.f};
    if (J.gain) { const f32x4 ga = *(const f32x4*)(J.gain + k0), gb = *(const f32x4*)(J.gain + k0 + 4);
#pragma unroll
        for (int jj = 0; jj < 4; ++jj) { v[jj] *= ga[jj]; v[4 + jj] *= gb[jj]; } }
#pragma unroll
    for (int e = 0; e < 4; ++e) { u32x4 w; w.x = cvt_pk_bf16(v[0][e], v[1][e]); w.y = cvt_pk_bf16(v[2][e], v[3][e]); w.z = cvt_pk_bf16(v[4][e], v[5][e]); w.w = cvt_pk_bf16(v[6][e], v[7][e]);
        __builtin_nontemporal_store(w, (u32x4*)(J.dst + (size_t)(n0 + e) * J.ldd + k0)); }
}
__device__ __forceinline__ void posb_item(const float* cpos, const float* cw1, unsigned char* wsb, int item, float* red, const int wv) {
    const int tid_o = TID_OPAQUE(wv);
    const int lj = item >> 3, hb = item & 7, t = tid_o, hid = hb * 32 + (t & 31), sl = t >> 5;
    const float* pp = cpos + (size_t)lj * 4096 + sl * 256; const float* w = cw1 + (size_t)lj * 4096 * 256 + (size_t)sl * 256 * 256 + hid;
    float s = 0.f;
#pragma unroll 32
    for (int kk = 0; kk < 256; ++kk) s = fmaf(pp[kk], w[(size_t)kk * 256], s);
    __syncthreads();
    red[sl * 32 + (t & 31)] = s;
    __syncthreads();
    if (t < 32) { float a = 0.f;
#pragma unroll
        for (int i = 0; i < 16; ++i) a += red[i * 32 + t];
        ((float*)(wsb + WS_POSB))[lj * 256 + hb * 32 + t] = a; }
}
__device__ __forceinline__ void rms_first_row(const float* x, bf16_t* xb, float* rstd, int row, int lane) {
    const f32x4* xr = (const f32x4*)(x + (size_t)row * DM) + lane;
    f32x4 v[8]; float s = 0.f;
#pragma unroll
    for (int j = 0; j < 8; ++j) { v[j] = xr[64 * j]; s += (v[j][0] * v[j][0] + v[j][1] * v[j][1]) + (v[j][2] * v[j][2] + v[j][3] * v[j][3]); }
    const float rs = rsqrtf(wave_sum(s) * (1.f / DM) + EPS);
    if (lane == 0) rstd[row] = rs;
    u32x2* o = (u32x2*)(xb + (size_t)row * DM) + lane;
#pragma unroll
    for (int j = 0; j < 8; ++j) { u32x2 w; w.x = cvt_pk_bf16(v[j][0] * rs, v[j][1] * rs); w.y = cvt_pk_bf16(v[j][2] * rs, v[j][3] * rs); o[64 * j] = w; }
}
__device__ __forceinline__ void rms_post_row(const float* xf32, const bf16_t* y, const float* ga, bf16_t* xb, float* rstd, float* xout, int row, int lane) {
    const u32x2* yr = (const u32x2*)(y + (size_t)row * DM) + lane; const f32x4* gar = (const f32x4*)ga + lane;
    u32x2* xbr = (u32x2*)(xb + (size_t)row * DM) + lane;
    f32x4 v[8], xv[8]; u32x2 yy[8]; float s = 0.f;
#pragma unroll
    for (int j = 0; j < 8; ++j) yy[j] = yr[64 * j];
    if (xf32) {
#pragma unroll
        for (int j = 0; j < 8; ++j) xv[j] = ((const f32x4*)(xf32 + (size_t)row * DM) + lane)[64 * j];
    } else { const float ir = 1.0f / rstd[row];
#pragma unroll
        for (int j = 0; j < 8; ++j) { const u32x2 xx = xbr[64 * j]; xv[j] = (f32x4){__uint_as_float(xx.x << 16) * ir, __uint_as_float(xx.x & 0xffff0000u) * ir, __uint_as_float(xx.y << 16) * ir, __uint_as_float(xx.y & 0xffff0000u) * ir}; }
    }
#pragma unroll
    for (int j = 0; j < 8; ++j) { v[j] = (f32x4){__uint_as_float(yy[j].x << 16), __uint_as_float(yy[j].x & 0xffff0000u), __uint_as_float(yy[j].y << 16), __uint_as_float(yy[j].y & 0xffff0000u)}; s += (v[j][0] * v[j][0] + v[j][1] * v[j][1]) + (v[j][2] * v[j][2] + v[j][3] * v[j][3]); }
    const float rsy = rsqrtf(wave_sum(s) * (1.f / DM) + EPS);
    float s2 = 0.f;
#pragma unroll
    for (int j = 0; j < 8; ++j) { const f32x4 gg = gar[64 * j];
#pragma unroll
        for (int i = 0; i < 4; ++i) v[j][i] = xv[j][i] + v[j][i] * rsy * gg[i];
        s2 += (v[j][0] * v[j][0] + v[j][1] * v[j][1]) + (v[j][2] * v[j][2] + v[j][3] * v[j][3]); }
    if (xout) { f32x4* xo = (f32x4*)(xout + (size_t)row * DM) + lane;
#pragma unroll
        for (int j = 0; j < 8; ++j) xo[64 * j] = v[j]; }
    else { const float rsx = rsqrtf(wave_sum(s2) * (1.f / DM) + EPS); if (lane == 0) rstd[row] = rsx;
#pragma unroll
        for (int j = 0; j < 8; ++j) { u32x2 n; n.x = cvt_pk_bf16(v[j][0] * rsx, v[j][1] * rsx); n.y = cvt_pk_bf16(v[j][2] * rsx, v[j][3] * rsx); xbr[64 * j] = n; } }
}
__device__ __forceinline__ void cumsum_item(int bh, const float* logf, float* cum, float* part, const int wv) {
    const int tid_o = TID_OPAQUE(wv);
    const int b = bh >> 2, h = bh & 3, t = tid_o;
    float v[8]; float s = 0.f;
#pragma unroll
    for (int i = 0; i < 8; ++i) { s += logf[((size_t)b * SEQ + t * 8 + i) * 4 + h]; v[i] = s; }
    __syncthreads();
    part[t] = s; __syncthreads();
    for (int o = 1; o < 512; o <<= 1) { float a = t >= o ? part[t - o] : 0.f; __syncthreads(); part[t] += a; __syncthreads(); }
    const float base = t ? part[t - 1] : 0.f;
#pragma unroll
    for (int i = 0; i < 8; ++i) cum[(size_t)bh * SEQ + t * 8 + i] = base + v[i];
}
__device__ __forceinline__ void cmp2_item(int item, const bf16_t* h1, const float* w2, bf16_t* kvc, const int wv) {
    const int tid_o = TID_OPAQUE(wv);
    const int row = item * 4 + (tid_o >> 7), n = tid_o & 127, panel = row >> 8, j = panel >> 3;
    const bf16_t* hr = h1 + (size_t)row * 256; const float* w = w2 + (size_t)j * 256 * 128 + n;
    float s = 0.f;
#pragma unroll 8
    for (int k = 0; k < 256; ++k) s = fmaf(bf2f(hr[k]), w[(size_t)k * 128], s);
    kvc[(size_t)row * 128 + n] = f2bf(s);
}
__device__ __forceinline__ void cmp2_panel(int panel, const bf16_t* h1, const bf16_t* w2t, bf16_t* kvc, const int wv) {
    const int lane = lane_id_opaque(), r32 = lane & 31, hi = lane >> 5, row = panel * 256 + 32 * wv + r32, j = panel >> 3;
    const bf16_t* hr = h1 + (size_t)row * 256 + 8 * hi;
    bf16x8 a[16];
#pragma unroll
    for (int s = 0; s < 16; ++s) a[s] = *(const bf16x8*)(hr + 16 * s);
#pragma unroll
    for (int nb = 0; nb < 4; ++nb) {
        f32x16 acc;
#pragma unroll
        for (int i = 0; i < 16; ++i) acc[i] = 0.f;
        const bf16_t* wr = w2t + ((size_t)j * 128 + 32 * nb + r32) * 256 + 8 * hi;
#pragma unroll
        for (int s = 0; s < 16; ++s) { const bf16x8 bw = *(const bf16x8*)(wr + 16 * s); acc = __builtin_amdgcn_mfma_f32_32x32x16_bf16(bw, a[s], acc, 0, 0, 0); }
#pragma unroll
        for (int gq = 0; gq < 4; ++gq) { u32x2 w; w.x = cvt_pk_bf16(acc[4 * gq], acc[4 * gq + 1]); w.y = cvt_pk_bf16(acc[4 * gq + 2], acc[4 * gq + 3]);
            *(u32x2*)(kvc + (size_t)row * 128 + 32 * nb + 8 * gq + 4 * hi) = w; }
        __builtin_amdgcn_sched_barrier(0);
    }
}
struct CmpOrder2 {
    int c;
    __device__ bool next(int i, pg8::Unit& u) const { if (i > 0 || c < 0 || c >= 16) return false; u.pm = c; u.pn = c >> 3; return true; }
};

__device__ __forceinline__ KParams opq_kp() { KParams k = (KParams)__builtin_amdgcn_kernarg_segment_ptr(); asm volatile("" : "+s"(k)); return k; }
#define GAS __attribute__((address_space(1)))
template <class Tp> __device__ __forceinline__ Tp* as_global(Tp* p) { return (Tp*)(GAS Tp*)p; }
#define PRM(f) (as_global(opq_kp()->f))
constexpr int CVT_NJ = 12;
constexpr int cvt_ntile(int j) { return j == 0 ? 23 * 32 : j == 1 ? 24 * 32 : j == 2 ? 8 * 8 : j == 3 ? 8 * 8 : j == 4 ? 8 * 16 : j == 5 ? 8 * 32 : j == 6 ? 44 * 32 : j == 7 ? 8 * 88 : j == 8 ? 64 : j == 9 ? 64 : 4; }
constexpr int cvt_pre(int j) { int s = 0; for (int i = 0; i < j; ++i) s += cvt_ntile(i); return s; }
constexpr int CVT_TILES = cvt_pre(CVT_NJ);
__device__ __forceinline__ void cvt_global_tile(int l, int gt, const int wv) {
    int j = 0;
#pragma unroll
    for (int i = 1; i < CVT_NJ; ++i) j += (gt >= cvt_pre(i)) ? 1 : 0;
    int pre = 0;
#pragma unroll
    for (int i = 1; i < CVT_NJ; ++i) pre = (gt >= cvt_pre(i)) ? cvt_pre(i) : pre;
    const CvtJob J = cvt_job(opq_kp(), l, j);
    cvt_tile(J, gt - pre, wv);
}
__device__ __forceinline__ void flag_wait(unsigned* flag, unsigned* bar, const int wv) {
    __syncthreads();
    if (TID_OPAQUE(wv) == 0) { XB_SPIN(xb_ld(flag) < 16u, bar); __builtin_amdgcn_fence(__ATOMIC_ACQUIRE, "agent"); asm volatile("s_waitcnt vmcnt(0)" ::: "memory"); }
    __syncthreads();
}
#define OPQ_WS() ({ GAS unsigned char* w_ = (GAS unsigned char*)(opq_kp()->ws); asm volatile("" : "+s"(w_)); w_; })
#define WSP(ty, off) ((ty*)(ws + (off)))
__global__ __launch_bounds__(512, 2) void k_mega(Params p_unused) {
    extern __shared__ __attribute__((aligned(16))) unsigned char shm[];
    LAS unsigned char* lds = (LAS unsigned char*)shm;
    const int wv = __builtin_amdgcn_readfirstlane((int)threadIdx.x >> 6), G = (int)gridDim.x, bid = (int)blockIdx.x;
    if (TID_OPAQUE(wv) == 0) *(uint4*)(shm + LDS_BARW) = make_uint4(0u, 0u, 0u, 0u);
    __syncthreads();
    XcdBarrier bar = xcd_barrier_post((unsigned*)(PRM(ws) + WS_CTL), (volatile LAS unsigned*)(lds + LDS_BARW), wv);

    for (int gt = bid; gt < CVT_TILES; gt += G) cvt_global_tile(0, gt, wv);
    for (int it = bid; it < NLAYER * 2 * 8; it += G) posb_item(PRM(cpos), PRM(cw1), PRM(ws), it, (float*)shm, wv);
    { GAS unsigned char* ws = OPQ_WS(); const int t_ = TID_OPAQUE(wv); for (int k_ = 0; k_ * G * 8 < T; ++k_) for (int row = (G == 256 ? (bid & 7) * 2048 + (bid >> 3) * 64 + k_ * 8 : bid * 8 + k_ * G * 8) + (t_ >> 6), once_ = 1; once_ && row < T; once_ = 0) rms_first_row(PRM(x_in), WSP(bf16_t, WS_HB), WSP(float, WS_RSTD), row, t_ & 63); }
    xcd_barrier(bar, wv);

    for (int l = 0; l < NLAYER; ++l) {
        const float lam_init = __int_as_float(__builtin_amdgcn_readfirstlane(__float_as_int(l == 0 ? 0.2f : (l == 1 ? 0.35550906759096934f : (l == 2 ? 0.4707130183435842f : 0.5560582041556406f)))));
        const float oml = __int_as_float(__builtin_amdgcn_readfirstlane(__float_as_int(l == 0 ? 0.8f : (l == 1 ? 0.64449093240903066f : (l == 2 ? 0.5292869816564158f : 0.4439417958443594f)))));
        { GAS unsigned char* ws = OPQ_WS(); const bf16_t* W = WSP(bf16_t, WS_W) + (size_t)l * LW_EL;
          pg8::Gemm g{}; g.A = WSP(bf16_t, WS_HB); g.Bt = W + OFF_W1T; g.M = T; g.N = N1; g.K = DM; g.lda = DM; g.ldb = DM;
          pg8::Epi1 e{}; e.qkv = WSP(bf16_t, WS_QKV); e.logf = WSP(float, WS_LOGF); e.nsag = WSP(float, WS_NSAG); e.gates = WSP(bf16_t, WS_GATES); e.fbias = PRM(fbias) + l * 4; e.rstd = WSP(float, WS_RSTD); e.kbound = (unsigned*)(ws + WS_CTL + CTL_KB) + l * 256;
          int bq = bid; asm volatile("" : "+s"(bq)); pg8::StaticOrder S; S.init(g.M, g.N, G, bq);
          pg8::gemm_phase<pg8::Epi1, pg8::StaticOrder>(lds, g, S, e, wv); }
        if (l + 1 < NLAYER && bid >= (64 * 47) % G) { GAS unsigned char* ws = OPQ_WS(); unsigned* ctr = (unsigned*)(ws + WS_CTL + 16384) + 64 * ((l * 4 + 3) * 8); LAS int* slot = (LAS int*)(lds + att::L_SLOT);
          const int it = att::queue_next(ctr, slot, wv);
          if (it * 8 < CVT_TILES) {
#pragma unroll 1
              for (int u = 0; u < 8; ++u) { const int gt = it * 8 + u; if (gt < CVT_TILES) cvt_global_tile(l + 1, gt, wv); } }
          __syncthreads(); }
        xcd_barrier(bar, wv);
        { GAS unsigned char* ws = OPQ_WS(); const bf16_t* W = WSP(bf16_t, WS_W) + (size_t)l * LW_EL;
          int bq = bid; asm volatile("" : "+s"(bq));
          pg8::Gemm g{}; g.A = WSP(bf16_t, WS_QKV) + (size_t)SL_NKC * 4 * SEQ * HD; g.Bt = W + OFF_WC1; g.M = 4096; g.N = 512; g.K = 4096; g.lda = 2048; g.ldb = 4096;
          pg8::EpiC1 e{}; e.h1 = WSP(bf16_t, WS_H1); e.posb = WSP(float, WS_POSB) + l * 512;
          CmpOrder2 S; S.c = bq;
          pg8::gemm_phase<pg8::EpiC1, CmpOrder2>(lds, g, S, e, wv);
          if (bq < 16) { asm volatile("s_waitcnt vmcnt(0)" ::: "memory"); __syncthreads();
              cmp2_panel(bq, WSP(bf16_t, WS_H1), W + OFF_WC2, WSP(bf16_t, WS_KVC), wv); }
          else if (bq < 32) cumsum_item(bq - 16, WSP(float, WS_LOGF), WSP(float, WS_CUM), (float*)shm, wv);
          if (bq < 32) {
              asm volatile("s_waitcnt vmcnt(0)" ::: "memory"); __syncthreads();
              if (TID_OPAQUE(wv) == 0) { __builtin_amdgcn_fence(__ATOMIC_RELEASE, "agent"); xb_add((unsigned*)(ws + WS_CTL + 49152) + 64 * (l * 2 + (bq >> 4)), 1u); } } }
        { GAS unsigned char* ws = OPQ_WS(); LAS int* slot = (LAS int*)(lds + att::L_SLOT); const int myx = (int)(xb_xcc_id() & 7u);
          for (int dx = 0; dx < 8; ++dx) { const int x = (myx + dx) & 7; unsigned* ctr = (unsigned*)(ws + WS_CTL + 16384) + 64 * ((l * 4 + 1) * 8 + x);
            for (;;) { const int it = att::queue_next(ctr, slot, wv); if (it >= 32) break;
              att::diff_item((x >> 1) * 4 + 2 + (x & 1), 31 - it, lds, WSP(bf16_t, WS_QKV), (const unsigned*)(ws + WS_CTL + CTL_KB) + l * 256, PRM(dlam) + l * 256, PRM(subln) + l * 128, lam_init, oml, WSP(bf16_t, WS_ATT), wv); } }
          __syncthreads(); }
        { GAS unsigned char* ws = OPQ_WS(); LAS int* slot = (LAS int*)(lds + att::L_SLOT); const int myx = (int)(xb_xcc_id() & 7u);
          flag_wait((unsigned*)(ws + WS_CTL + 49152) + 64 * (l * 2 + 1), (unsigned*)(ws + WS_CTL), wv);
          for (int dx = 0; dx < 8; ++dx) { const int x = (myx + dx) & 7; unsigned* ctr = (unsigned*)(ws + WS_CTL + 16384) + 64 * ((l * 4 + 0) * 8 + x);
            for (;;) { const int it = att::queue_next(ctr, slot, wv); if (it >= 32) break;
              att::fox_item(2 * x + (it & 1), 15 - (it >> 1), lds, WSP(bf16_t, WS_QKV), WSP(float, WS_CUM), WSP(bf16_t, WS_ATT), wv); } }
          __syncthreads(); }
        { GAS unsigned char* ws = OPQ_WS(); LAS int* slot = (LAS int*)(lds + att::L_SLOT); const int myx = (int)(xb_xcc_id() & 7u);
          flag_wait((unsigned*)(ws + WS_CTL + 49152) + 64 * (l * 2 + 0), (unsigned*)(ws + WS_CTL), wv);
          for (int dx = 0; dx < 8; ++dx) { const int x = (myx + dx) & 7; unsigned* ctr = (unsigned*)(ws + WS_CTL + 16384) + 64 * ((l * 4 + 2) * 8 + x);
            for (;;) { const int it = att::queue_next(ctr, slot, wv); if (it >= 64) break;
              att::nsa_item(x, 63 - it, lds, WSP(bf16_t, WS_QKV), WSP(bf16_t, WS_KVC), WSP(float, WS_NSAG), (const unsigned*)(ws + WS_CTL + CTL_KB) + l * 256, WSP(bf16_t, WS_ATT), wv); } }
          __syncthreads(); }
        { GAS unsigned char* ws = OPQ_WS(); LAS int* slot = (LAS int*)(lds + att::L_SLOT); const int myx = (int)(xb_xcc_id() & 7u);
          for (int dx = 0; dx < 8; ++dx) { const int x = (myx + dx) & 7; unsigned* ctr = (unsigned*)(ws + WS_CTL + 53248) + 64 * (l * 8 + x);
            for (;;) { const int it = att::queue_next(ctr, slot, wv); if (it >= 32) break;
              att::diff_item((x >> 1) * 4 + (x & 1), 31 - it, lds, WSP(bf16_t, WS_QKV), (const unsigned*)(ws + WS_CTL + CTL_KB) + l * 256, PRM(dlam) + l * 256, PRM(subln) + l * 128, lam_init, oml, WSP(bf16_t, WS_ATT), wv); } }
          __syncthreads(); }
        if (l + 1 < NLAYER) { GAS unsigned char* ws = OPQ_WS(); unsigned* ctr = (unsigned*)(ws + WS_CTL + 16384) + 64 * ((l * 4 + 3) * 8); LAS int* slot = (LAS int*)(lds + att::L_SLOT);
          for (;;) { const int it = att::queue_next(ctr, slot, wv); if (it * 8 >= CVT_TILES) break;
#pragma unroll 1
              for (int u = 0; u < 8; ++u) { const int gt = it * 8 + u; if (gt < CVT_TILES) cvt_global_tile(l + 1, gt, wv); } }
          __syncthreads(); }
        xcd_barrier(bar, wv);
        { GAS unsigned char* ws = OPQ_WS(); const bf16_t* W = WSP(bf16_t, WS_W) + (size_t)l * LW_EL;
          pg8::Gemm g{}; g.A = WSP(bf16_t, WS_ATT); g.Bt = W + OFF_WBT; g.M = T; g.N = DM; g.K = DM; g.lda = DM; g.ldb = DM;
          pg8::Epi2 e{}; e.gates = WSP(bf16_t, WS_GATES); e.out = WSP(bf16_t, WS_MRG);
          int bq = bid; asm volatile("" : "+s"(bq)); pg8::StaticOrder S; S.init(g.M, g.N, G, bq);
          pg8::gemm_phase<pg8::Epi2, pg8::StaticOrder>(lds, g, S, e, wv); }
        xcd_barrier(bar, wv);
        { GAS unsigned char* ws = OPQ_WS(); const bf16_t* W = WSP(bf16_t, WS_W) + (size_t)l * LW_EL;
          pg8::Gemm g{}; g.A = WSP(bf16_t, WS_MRG); g.Bt = W + OFF_WOT; g.M = T; g.N = DM; g.K = DM; g.lda = DM; g.ldb = DM;
          pg8::EpiBf16P e{}; e.C = WSP(bf16_t, WS_Y); e.ldc = DM;
          int bq = bid; asm volatile("" : "+s"(bq)); pg8::StaticOrder S; S.init(g.M, g.N, G, bq);
          pg8::gemm_phase<pg8::EpiBf16P, pg8::StaticOrder>(lds, g, S, e, wv); }
        xcd_barrier(bar, wv);
        { GAS unsigned char* ws = OPQ_WS(); const float* gl = PRM(gains) + (size_t)l * 4 * DM; const int t_ = TID_OPAQUE(wv);
          for (int k_ = 0; k_ * G * 8 < T; ++k_) for (int row = (G == 256 ? (bid & 7) * 2048 + (bid >> 3) * 64 + k_ * 8 : bid * 8 + k_ * G * 8) + (t_ >> 6), once_ = 1; once_ && row < T; once_ = 0) rms_post_row(l == 0 ? PRM(x_in) : (const float*)nullptr, WSP(bf16_t, WS_Y), gl + DM, WSP(bf16_t, WS_HB), WSP(float, WS_RSTD), (float*)nullptr, row, t_ & 63); }
        xcd_barrier(bar, wv);
        { GAS unsigned char* ws = OPQ_WS(); const bf16_t* W = WSP(bf16_t, WS_W) + (size_t)l * LW_EL;
          pg8::Gemm g{}; g.A = WSP(bf16_t, WS_HB); g.Bt = W + OFF_WUP; g.M = T; g.N = 2 * DFF; g.K = DM; g.lda = DM; g.ldb = DM;
          pg8::EpiSwiGLU e{}; e.hid = WSP(bf16_t, WS_HID); e.rstd = WSP(float, WS_RSTD);
          int bq = bid; asm volatile("" : "+s"(bq)); pg8::StaticOrder S; S.init(g.M, g.N, G, bq);
          pg8::gemm_phase<pg8::EpiSwiGLU, pg8::StaticOrder>(lds, g, S, e, wv); }
        xcd_barrier(bar, wv);
        { GAS unsigned char* ws = OPQ_WS(); const bf16_t* W = WSP(bf16_t, WS_W) + (size_t)l * LW_EL;
          pg8::Gemm g{}; g.A = WSP(bf16_t, WS_HID); g.Bt = W + OFF_WDN; g.M = T; g.N = DM; g.K = DFF; g.lda = DFF; g.ldb = DFF;
          pg8::EpiBf16P e{}; e.C = WSP(bf16_t, WS_Y); e.ldc = DM;
          int bq = bid; asm volatile("" : "+s"(bq)); pg8::StaticOrder S; S.init(g.M, g.N, G, bq);
          pg8::gemm_phase<pg8::EpiBf16P, pg8::StaticOrder>(lds, g, S, e, wv); }
        xcd_barrier(bar, wv);
        { GAS unsigned char* ws = OPQ_WS(); const float* gl = PRM(gains) + (size_t)l * 4 * DM; const int t_ = TID_OPAQUE(wv);
          for (int k_ = 0; k_ * G * 8 < T; ++k_) for (int row = (G == 256 ? (bid & 7) * 2048 + (bid >> 3) * 64 + k_ * 8 : bid * 8 + k_ * G * 8) + (t_ >> 6), once_ = 1; once_ && row < T; once_ = 0) rms_post_row((const float*)nullptr, WSP(bf16_t, WS_Y), gl + 3 * DM, WSP(bf16_t, WS_HB), WSP(float, WS_RSTD), l + 1 < NLAYER ? (float*)nullptr : PRM(xo), row, t_ & 63); }
        if (l + 1 < NLAYER) xcd_barrier(bar, wv);
    }
}

extern "C" void kernel_launch(void* const* d_in, const int* in_sizes, int n_in, void* d_out, int out_size, void* d_ws, size_t ws_size, hipStream_t stream) {
    static int grid = 0;
    if (grid == 0) {
        if (n_in != 16 || ws_size < WS_END) { fprintf(stderr, "kernel_launch: bad arguments n_in %d ws %zu need %zu\n", n_in, ws_size, (size_t)WS_END); grid = -1; return; }
        int dev = 0, cus = 0, per_cu = 0;
        if (hipGetDevice(&dev) != hipSuccess || hipDeviceGetAttribute(&cus, hipDeviceAttributeMultiprocessorCount, dev) != hipSuccess) { grid = -1; return; }
        if (hipFuncSetAttribute((const void*)k_mega, hipFuncAttributeMaxDynamicSharedMemorySize, LDS_TOTAL) != hipSuccess) { fprintf(stderr, "kernel_launch: hipFuncSetAttribute failed\n"); grid = -1; return; }
        if (hipOccupancyMaxActiveBlocksPerMultiprocessor(&per_cu, (const void*)k_mega, 512, LDS_TOTAL) != hipSuccess || per_cu < 1) { fprintf(stderr, "kernel_launch: occupancy query says %d\n", per_cu); }
        (void)hipGetLastError();
        grid = cus > 0 ? cus : 256;
    }
    if (grid < 0) return;
    if (hipMemsetAsync((char*)d_ws + WS_CTL, 0, CTL_BYTES, stream) != hipSuccess) return;
    Params p{};
    p.x_in = (const float*)d_in[0]; p.w_in = (const float*)d_in[1]; p.fbias = (const float*)d_in[2]; p.dlam = (const float*)d_in[3]; p.subln = (const float*)d_in[4];
    p.cpos = (const float*)d_in[5]; p.cw1 = (const float*)d_in[6]; p.cw2 = (const float*)d_in[7]; p.wbf = (const float*)d_in[8]; p.wbd = (const float*)d_in[9];
    p.wbn = (const float*)d_in[10]; p.wgate = (const float*)d_in[11]; p.wout = (const float*)d_in[12]; p.gains = (const float*)d_in[13]; p.wup = (const float*)d_in[14];
    p.wdn = (const float*)d_in[15]; p.xo = (float*)d_out; p.ws = (unsigned char*)d_ws;
    hipLaunchKernelGGL(k_mega, dim3(grid), dim3(512), LDS_TOTAL, stream, p);
}
```

```cpp
#include <hip/hip_runtime.h>
#include <cstdio>
#include <cstdint>
#include <cmath>

#define LAS __attribute__((address_space(3)))
typedef unsigned short bf16_t;
typedef short bf16x8 __attribute__((ext_vector_type(8)));
typedef short s16x4 __attribute__((ext_vector_type(4)));
typedef float f32x4 __attribute__((ext_vector_type(4)));
typedef float f32x16 __attribute__((ext_vector_type(16)));
typedef unsigned u32x4 __attribute__((ext_vector_type(4)));
typedef unsigned u32x2 __attribute__((ext_vector_type(2)));

constexpr int T = 16384, DM = 2048, NBATCH = 4, SEQ = 4096, NLAYER = 4;
constexpr int IN_COLS = 5660, DFF = 5632, HD = 128;
constexpr int N1 = 12032;
constexpr int NSLOT = 44;
constexpr float EPS = 1e-6f;

constexpr int SL_FQ = 0, SL_FK = 4, SL_FV = 8, SL_DQ = 12, SL_DK = 16, SL_DV = 20, SL_NQ = 24, SL_NKC = 32, SL_NVC = 34, SL_NKS = 36, SL_NVS = 38, SL_NKW = 40, SL_NVW = 42;

constexpr size_t al256(size_t x) { return (x + 255) & ~(size_t)255; }
constexpr size_t WS_CTL   = 0;
constexpr size_t CTL_BYTES = 131072;
constexpr size_t CTL_KB = 65536;
constexpr size_t W1T_EL  = (size_t)N1 * DM;
constexpr size_t WBT_EL  = (size_t)DM * DM;
constexpr size_t WOT_EL  = (size_t)DM * DM;
constexpr size_t WUP_EL  = (size_t)2 * DFF * DM;
constexpr size_t WDN_EL  = (size_t)DM * DFF;
constexpr size_t WC1_EL  = (size_t)2 * 256 * 4096;
constexpr size_t WC2_EL  = (size_t)2 * 128 * 256;
constexpr size_t LW_EL   = W1T_EL + WBT_EL + WOT_EL + WUP_EL + WDN_EL + WC1_EL + WC2_EL;
constexpr size_t OFF_W1T = 0, OFF_WBT = OFF_W1T + W1T_EL, OFF_WOT = OFF_WBT + WBT_EL, OFF_WUP = OFF_WOT + WOT_EL, OFF_WDN = OFF_WUP + WUP_EL, OFF_WC1 = OFF_WDN + WDN_EL, OFF_WC2 = OFF_WC1 + WC1_EL;
constexpr size_t WS_W     = WS_CTL + CTL_BYTES;
constexpr size_t WS_POSB  = al256(WS_W + (size_t)NLAYER * LW_EL * 2);
constexpr size_t WS_HB    = al256(WS_POSB + (size_t)NLAYER * 2 * 256 * 4);
constexpr size_t WS_QKV   = al256(WS_HB + (size_t)T * DM * 2);
constexpr size_t QKV_BYTES = (size_t)NSLOT * NBATCH * SEQ * HD * 2;
constexpr size_t WS_GATES = al256(WS_QKV + QKV_BYTES + 65536);
constexpr size_t WS_HID   = WS_QKV;
constexpr size_t WS_ATT   = al256(WS_GATES + (size_t)3 * T * DM * 2);
constexpr size_t WS_MRG   = al256(WS_ATT + (size_t)T * DM * 2);
constexpr size_t WS_Y     = al256(WS_MRG + (size_t)T * DM * 2);
constexpr size_t WS_LOGF  = al256(WS_Y + (size_t)T * DM * 4);
constexpr size_t WS_NSAG  = al256(WS_LOGF + (size_t)T * 4 * 4);
constexpr size_t WS_CUM   = al256(WS_NSAG + (size_t)T * 24 * 4);
constexpr size_t WS_H1    = al256(WS_CUM + (size_t)16 * SEQ * 4);
constexpr size_t WS_KVC   = al256(WS_H1 + (size_t)16 * 256 * 256 * 2);
constexpr size_t WS_SELM  = al256(WS_KVC + (size_t)16 * 256 * 128 * 2);
constexpr size_t WS_RSTD  = al256(WS_SELM + (size_t)NBATCH * 2 * SEQ * 8);
constexpr size_t WS_XR    = al256(WS_RSTD + (size_t)T * 4);
constexpr size_t WS_END   = al256(WS_XR + (size_t)T * DM * 2);
static_assert((size_t)T * DFF * 2 <= (WS_ATT - WS_QKV), "HID overlay must fit in QKV + GATES");

__device__ __forceinline__ float bf2f(bf16_t b) { return __uint_as_float(((unsigned)b) << 16); }
__device__ __forceinline__ bf16_t f2bf(float f) { unsigned u = __float_as_uint(f); u += 0x7FFFu + ((u >> 16) & 1u); return (bf16_t)(u >> 16); }
typedef __bf16 bf16v2_t __attribute__((ext_vector_type(2)));
typedef float f32v2_t __attribute__((ext_vector_type(2)));
__device__ __forceinline__ unsigned cvt_pk_bf16(float lo, float hi) { const f32v2_t v = {lo, hi}; const bf16v2_t b = __builtin_convertvector(v, bf16v2_t); return __builtin_bit_cast(unsigned, b); }
__device__ __forceinline__ float sigmoidf_(float v) { return __builtin_amdgcn_rcpf(1.0f + __expf(-v)); }
#define SWZ_XOR(v, k) __int_as_float(__builtin_amdgcn_ds_swizzle(__float_as_int(v), ((k) << 10) | 0x1f))
__device__ __forceinline__ float wave_sum(float v) {
    v += SWZ_XOR(v, 1); v += SWZ_XOR(v, 2); v += SWZ_XOR(v, 4); v += SWZ_XOR(v, 8); v += SWZ_XOR(v, 16);
    auto rr = __builtin_amdgcn_permlane32_swap(__float_as_uint(v), __float_as_uint(v), false, false); return __uint_as_float(rr[0]) + __uint_as_float(rr[1]);
}
__device__ __forceinline__ float wave_max(float v) {
    v = fmaxf(v, SWZ_XOR(v, 1)); v = fmaxf(v, SWZ_XOR(v, 2)); v = fmaxf(v, SWZ_XOR(v, 4)); v = fmaxf(v, SWZ_XOR(v, 8)); v = fmaxf(v, SWZ_XOR(v, 16));
    auto rr = __builtin_amdgcn_permlane32_swap(__float_as_uint(v), __float_as_uint(v), false, false); return fmaxf(__uint_as_float(rr[0]), __uint_as_float(rr[1]));
}

__device__ __forceinline__ int lane_id_opaque() { int l = (int)__builtin_amdgcn_mbcnt_hi(~0u, __builtin_amdgcn_mbcnt_lo(~0u, 0u)); asm volatile("" : "+v"(l)); return l; }
#define TID_OPAQUE(wv) ((wv) * 64 + lane_id_opaque())

namespace pg8 {
constexpr int BM = 256, BK = 64, HALF = 128, HTB = HALF * BK * 2, STAGE_BYTES = 8 * HTB, NXCD = 8, WGM = 4;
__host__ __device__ __forceinline__ int lds_byte(int r, int c) { const int st = (r >> 4) * 2 + (c >> 5), rr = r & 15, cc = c & 31, ob = rr * 64 + cc * 2; return st * 1024 + (ob ^ (((ob >> 9) & 1) << 5)); }
__host__ __device__ __forceinline__ void stage_rc(int b, int& R, int& C) { const int st = b / 1024, sb = b % 1024, swz = sb ^ (((sb >> 9) & 1) << 5); R = (st >> 1) * 16 + swz / 64; C = (st & 1) * 32 + (swz % 64) / 2; }
__host__ __device__ __forceinline__ int perm32(int rho) { const int n = rho >> 4, i = rho & 15; return 8 * (i >> 2) + 4 * n + (i & 3); }

struct Unit { int pm, pn, ko; };
struct Gemm { const bf16_t* A; const bf16_t* Bt; int M, N, K, lda, ldb, pad; };

struct StaticOrder {
    int nM, nN, nwg, G, c;
    __host__ __device__ void init(int M, int N, int G_, int c_) { nM = M / BM; nN = N / BM; nwg = nM * nN; G = G_; c = c_; }
    __host__ __device__ bool next(int i, Unit& u) const {
        const long L = (long)i * G + c; if (L >= nwg) return false;
        int wgid = (int)L; { const int q = nwg / NXCD, r = nwg % NXCD, xcd = wgid % NXCD, off = wgid / NXCD; wgid = (xcd < r ? xcd * (q + 1) : r * (q + 1) + (xcd - r) * q) + off; }
        const int nig = WGM * nN, gid = wgid / nig, fm = gid * WGM, gsz = (nM - fm) < WGM ? (nM - fm) : WGM;
        u.pm = fm + ((wgid % nig) % gsz); u.pn = (wgid % nig) / gsz; u.ko = 0; return true;
    }
};
struct CmpOrder {
    int G, c;
    __host__ __device__ void init(int, int, int G_, int c_) { G = G_; c = c_; }
    __host__ __device__ bool next(int i, Unit& u) const { const int Lx = i * G + c; if (Lx >= 16) return false; u.pm = Lx; u.pn = Lx >> 3; u.ko = 0; return true; }
};

typedef f32x4 Acc[2][2][4][2];

template <class Epi, class Sched>
__device__ __forceinline__ void gemm_phase(LAS unsigned char* lds, const Gemm g, const Sched& S, const Epi& E, const int wv) {
    int wid_o = wv; asm volatile("" : "+s"(wid_o));
    const int wid = wid_o, tid = wid * 64 + lane_id_opaque(), lane = tid & 63, wr = wid >> 2, wc = wid & 3, fr = lane & 15, fq = lane >> 4;
    const int K = g.K, nt = K / BK;
    unsigned voffA[2], voffB[2];
#pragma unroll
    for (int i = 0; i < 2; ++i) { int R, C; stage_rc(tid * 16 + i * 8192, R, C); const int Rb = Epi::PERM ? ((R & ~31) + perm32(R & 31)) : R;
        voffA[i] = (unsigned)(R * g.lda + C) * 2u; voffB[i] = (unsigned)(Rb * g.ldb + C) * 2u; }
    const size_t kstep = (size_t)(BK * 2);
    const size_t hstepA = (size_t)HALF * g.lda * 2, hstepB = (size_t)HALF * g.ldb * 2;
    const size_t tstepA = 2 * hstepA, tstepB = 2 * hstepB;
    const unsigned ldsw = (unsigned)wid * 1024u;
    const int aoff = lds_byte(wr * 64 + fr, fq * 8), boff = lds_byte(wc * 32 + fr, fq * 8);
#define PG8_SA(b, h) (((b) * 2 + (h)) * HTB)
#define PG8_SB(b, h) ((4 + (b) * 2 + (h)) * HTB)
#define PG8_STAGE(bufoff, gbase, voff) do { _Pragma("unroll") for (int _i = 0; _i < 2; ++_i) \
        __builtin_amdgcn_global_load_lds((const unsigned*)((const char*)(gbase) + (voff)[_i]), (LAS unsigned*)(lds + (bufoff) + ldsw + _i * 8192), 16, 0, 0); } while (0)
#define PG8_LDA(dst, b, h) do { _Pragma("unroll") for (int m = 0; m < 4; ++m) _Pragma("unroll") for (int k = 0; k < 2; ++k) dst[m][k] = *(const LAS bf16x8*)(lds + PG8_SA(b, h) + aoff + m * 2048 + k * 1024); } while (0)
#define PG8_LDB(dst, b, h) do { _Pragma("unroll") for (int n = 0; n < 2; ++n) _Pragma("unroll") for (int k = 0; k < 2; ++k) dst[n][k] = *(const LAS bf16x8*)(lds + PG8_SB(b, h) + boff + n * 2048 + k * 1024); } while (0)
#define PG8_MMA(ai, bj, At, Bt) do { __builtin_amdgcn_s_setprio(1); _Pragma("unroll") for (int m = 0; m < 4; ++m) _Pragma("unroll") for (int n = 0; n < 2; ++n) _Pragma("unroll") for (int k = 0; k < 2; ++k) \
        acc[ai][bj][m][n] = __builtin_amdgcn_mfma_f32_16x16x32_bf16(Bt[n][k], At[m][k], acc[ai][bj][m][n], 0, 0, 0); __builtin_amdgcn_s_setprio(0); } while (0)
#define PG8_WAIT_V(n) asm volatile("s_waitcnt vmcnt(" #n ")" ::: "memory")
#define PG8_WAIT_L(n) asm volatile("s_waitcnt lgkmcnt(" #n ")" ::: "memory")
#define PG8_BAR __builtin_amdgcn_s_barrier()
#define PG8_SCHED __builtin_amdgcn_sched_barrier(0)
    Unit cur, nxt; int ui = 0;
    if (!S.next(0, cur)) return;
    f32x4 acc[2][2][4][2];
#pragma unroll
    for (int a = 0; a < 2; ++a)
#pragma unroll
        for (int b = 0; b < 2; ++b)
#pragma unroll
            for (int m = 0; m < 4; ++m)
#pragma unroll
                for (int n = 0; n < 2; ++n) acc[a][b][m][n] = (f32x4){0.f, 0.f, 0.f, 0.f};
    bf16x8 At[4][2], B0[2][2], B1[2][2];
    const char* cA = (const char*)g.A + (size_t)cur.pm * tstepA + (size_t)cur.ko * 2; const char* cB = (const char*)g.Bt + (size_t)cur.pn * tstepB + (size_t)cur.ko * 2;
    PG8_STAGE(PG8_SB(0, 0), cB, voffB); PG8_STAGE(PG8_SB(0, 1), cB + hstepB, voffB); PG8_STAGE(PG8_SA(0, 0), cA, voffA); PG8_STAGE(PG8_SA(0, 1), cA + hstepA, voffA);
    if (wr == 1) PG8_BAR;
    PG8_WAIT_V(2); PG8_BAR;
    PG8_STAGE(PG8_SB(1, 0), cB + kstep, voffB); PG8_STAGE(PG8_SA(1, 0), cA + kstep, voffA); PG8_STAGE(PG8_SB(1, 1), cB + hstepB + kstep, voffB);
    PG8_WAIT_V(6); PG8_BAR;
    for (;;) {
        const bool has_next = S.next(ui + 1, nxt);
        const char* nA = has_next ? (const char*)g.A + (size_t)nxt.pm * tstepA + (size_t)nxt.ko * 2 : cA; const char* nB = has_next ? (const char*)g.Bt + (size_t)nxt.pn * tstepB + (size_t)nxt.ko * 2 : cB;
        for (int t = 0; t < nt; t += 2) {
            if constexpr (Epi::HOOK) { if (t == Epi::H1 || t == Epi::H2) E.mid(acc, cur, t, wr, wc, fr, fq); }
            const bool last = (t == nt - 2);
            const char* a1 = cA + (size_t)(t + 1) * kstep;
            const char* a2 = last ? nA : cA + (size_t)(t + 2) * kstep; const char* b2 = last ? nB : cB + (size_t)(t + 2) * kstep;
            const char* a3 = a2 + kstep; const char* b3 = b2 + kstep;
            PG8_LDB(B0, 0, 0); PG8_LDB(B1, 0, 1); PG8_SCHED; PG8_LDA(At, 0, 0); PG8_STAGE(PG8_SA(1, 1), a1 + hstepA, voffA);
            PG8_WAIT_V(8); PG8_WAIT_L(0); PG8_BAR; PG8_MMA(0, 0, At, B0); PG8_MMA(0, 1, At, B1); PG8_BAR; PG8_SCHED;
            PG8_LDA(At, 0, 1); PG8_STAGE(PG8_SB(0, 0), b2, voffB); PG8_STAGE(PG8_SB(0, 1), b2 + hstepB, voffB); PG8_STAGE(PG8_SA(0, 0), a2, voffA);
            PG8_WAIT_V(8); PG8_WAIT_L(0); PG8_BAR; PG8_MMA(1, 0, At, B0); PG8_MMA(1, 1, At, B1); PG8_BAR; PG8_SCHED;
            PG8_LDB(B0, 1, 0); PG8_LDB(B1, 1, 1); PG8_SCHED; PG8_LDA(At, 1, 0); PG8_STAGE(PG8_SA(0, 1), a2 + hstepA, voffA);
            PG8_WAIT_V(8); PG8_WAIT_L(0); PG8_BAR; PG8_MMA(0, 0, At, B0); PG8_MMA(0, 1, At, B1); PG8_BAR; PG8_SCHED;
            PG8_LDA(At, 1, 1); PG8_STAGE(PG8_SB(1, 0), b3, voffB); PG8_STAGE(PG8_SB(1, 1), b3 + hstepB, voffB); PG8_STAGE(PG8_SA(1, 0), a3, voffA);
            PG8_WAIT_V(8); PG8_WAIT_L(0); PG8_BAR; PG8_MMA(1, 0, At, B0); PG8_MMA(1, 1, At, B1); PG8_BAR; PG8_SCHED;
        }
        if (wr == 0) PG8_BAR;
        E(acc, cur, wr, wc, fr, fq);
        if (!has_next) break;
#pragma unroll
        for (int a = 0; a < 2; ++a)
#pragma unroll
            for (int b = 0; b < 2; ++b)
#pragma unroll
                for (int m = 0; m < 4; ++m)
#pragma unroll
                    for (int n = 0; n < 2; ++n) acc[a][b][m][n] = (f32x4){0.f, 0.f, 0.f, 0.f};
        cur = nxt; cA = nA; cB = nB; ++ui;
        if (wr == 1) PG8_BAR;
    }
    PG8_WAIT_V(0);
    PG8_BAR;
#undef PG8_SA
#undef PG8_SB
#undef PG8_STAGE
#undef PG8_LDA
#undef PG8_LDB
#undef PG8_MMA
#undef PG8_WAIT_V
#undef PG8_WAIT_L
#undef PG8_BAR
#undef PG8_SCHED
}

__device__ __forceinline__ u32x4 pack8(const f32x4 v0, const f32x4 v1) { u32x4 w; w.x = cvt_pk_bf16(v0[0], v0[1]); w.y = cvt_pk_bf16(v0[2], v0[3]); w.z = cvt_pk_bf16(v1[0], v1[1]); w.w = cvt_pk_bf16(v1[2], v1[3]); return w; }

struct Epi1 {
    static constexpr bool PERM = true, HOOK = false; static constexpr int H1 = -1, H2 = -1;
    bf16_t* qkv; float* logf; float* nsag; bf16_t* gates; const float* fbias; const float* rstd; unsigned* kbound;
    __device__ __forceinline__ void operator()(const Acc& acc, const Unit& u, int wr, int wc, int fr, int fq) const {
        const int row0 = u.pm * BM + wr * 64 + fr;
        if (u.pn < 22) {
#pragma unroll
            for (int ai = 0; ai < 2; ++ai)
#pragma unroll
                for (int m = 0; m < 4; ++m) { const int r = row0 + ai * HALF + m * 16, b = r >> 12, s = r & 4095;
#pragma unroll
                    for (int bj = 0; bj < 2; ++bj) { const int slot = 2 * u.pn + bj;
                        bf16_t* dst = qkv + (((size_t)(slot * 4 + b) * SEQ + s) * HD + wc * 32 + 8 * fq);
                        *(u32x4*)dst = pack8(acc[ai][bj][m][0], acc[ai][bj][m][1]); } }
            if (u.pn == 8 || u.pn == 9 || u.pn == 18 || u.pn == 20) {
                float pmx[2] = {0.f, 0.f};
#pragma unroll
                for (int ai = 0; ai < 2; ++ai)
#pragma unroll
                    for (int m = 0; m < 4; ++m) {
#pragma unroll
                        for (int bj = 0; bj < 2; ++bj) { const f32x4 v0 = acc[ai][bj][m][0], v1 = acc[ai][bj][m][1];
                            const float ss = ((v0[0] * v0[0] + v0[1] * v0[1]) + (v0[2] * v0[2] + v0[3] * v0[3])) + ((v1[0] * v1[0] + v1[1] * v1[1]) + (v1[2] * v1[2] + v1[3] * v1[3]));
                            pmx[bj] = fmaxf(pmx[bj], ss); } }
#pragma unroll
                for (int bj = 0; bj < 2; ++bj) { float v = pmx[bj]; v = fmaxf(v, SWZ_XOR(v, 1)); v = fmaxf(v, SWZ_XOR(v, 2)); v = fmaxf(v, SWZ_XOR(v, 4)); v = fmaxf(v, SWZ_XOR(v, 8));
                    const int kr = u.pn < 10 ? (2 * u.pn + bj) - 16 : (u.pn == 18 ? 16 + bj : 18 + bj);
                    if (fr == 0) atomicMax(kbound + ((kr * 4 + (row0 >> 12)) * 16 + 4 * wc + fq), __float_as_uint(v)); }
            }
        } else if (u.pn == 22) {
            if (wc == 0) {
#pragma unroll
                for (int ai = 0; ai < 2; ++ai)
#pragma unroll
                    for (int m = 0; m < 4; ++m) { const int r = row0 + ai * HALF + m * 16;
#pragma unroll
                        for (int n = 0; n < 2; ++n)
#pragma unroll
                            for (int i = 0; i < 4; ++i) { const int c = 8 * fq + 4 * n + i; const float v = acc[ai][0][m][n][i];
                                if (c < 4) { const float z = v + fbias[c]; logf[(size_t)r * 4 + c] = fminf(z, 0.f) - log1pf(expf(-fabsf(z))); }
                                else if (c < 28) nsag[(size_t)r * 24 + (c - 4)] = 1.0f / (1.0f + expf(-v)); } }
            }
        } else {
            const int pg = u.pn - 23, bidx = pg >> 3, colt = (pg & 7) * 256;
            unsigned char* gq = (unsigned char*)gates;
#pragma unroll
            for (int ai = 0; ai < 2; ++ai)
#pragma unroll
                for (int m = 0; m < 4; ++m) { const int r = row0 + ai * HALF + m * 16;
#pragma unroll
                    for (int bj = 0; bj < 2; ++bj) { const f32x4 v0 = acc[ai][bj][m][0], v1 = acc[ai][bj][m][1]; u32x2 w = {0u, 0u};
#pragma unroll
                        for (int i = 0; i < 4; ++i) {
                            w.x = __builtin_amdgcn_cvt_pk_u8_f32(fmaxf(sigmoidf_(v0[i]) * 255.f, 1.f), i, w.x); w.y = __builtin_amdgcn_cvt_pk_u8_f32(fmaxf(sigmoidf_(v1[i]) * 255.f, 1.f), i, w.y); }
                        *(u32x2*)(gq + (((size_t)bidx * T + r) * DM + colt + bj * HALF + wc * 32 + 8 * fq)) = w; } }
        }
    }
};

struct Epi2 {
    static constexpr bool PERM = true, HOOK = true; static constexpr int H1 = 8, H2 = 16;
    const bf16_t* gates; bf16_t* out;
    __device__ __forceinline__ void mid(Acc& acc, const Unit& u, int t, int wr, int wc, int fr, int fq) const {
        int row0 = u.pm * BM + wr * 64 + fr; asm volatile("" : "+v"(row0));
        const unsigned char* ga = (const unsigned char*)gates + (t == H1 ? (size_t)0 : (size_t)T * DM); const unsigned char* gb = ga + (size_t)T * DM;
        u32x2 av[2][4][2], bv[2][4][2];
#pragma unroll
        for (int ai = 0; ai < 2; ++ai)
#pragma unroll
            for (int m = 0; m < 4; ++m)
#pragma unroll
                for (int bj = 0; bj < 2; ++bj) { const size_t o = (size_t)(row0 + ai * HALF + m * 16) * DM + u.pn * BM + bj * HALF + wc * 32 + 8 * fq;
                    av[ai][m][bj] = *(const u32x2*)(ga + o); bv[ai][m][bj] = *(const u32x2*)(gb + o); }
#pragma unroll
        for (int ai = 0; ai < 2; ++ai)
#pragma unroll
            for (int m = 0; m < 4; ++m)
#pragma unroll
                for (int bj = 0; bj < 2; ++bj)
#pragma unroll
                    for (int e = 0; e < 8; ++e) { const unsigned wa = e < 4 ? av[ai][m][bj].x : av[ai][m][bj].y, wb = e < 4 ? bv[ai][m][bj].x : bv[ai][m][bj].y;
                        const float fa = (float)((wa >> (8 * (e & 3))) & 255u), fb = (float)((wb >> (8 * (e & 3))) & 255u);
                        acc[ai][bj][m][e >> 2][e & 3] *= fa * __builtin_amdgcn_rcpf(fb); }
    }
    __device__ __forceinline__ void operator()(const Acc& acc, const Unit& u, int wr, int wc, int fr, int fq) const {
        const int row0 = u.pm * BM + wr * 64 + fr; const unsigned char* g2 = (const unsigned char*)gates + (size_t)2 * T * DM;
        u32x2 gv[2][4][2];
#pragma unroll
        for (int ai = 0; ai < 2; ++ai)
#pragma unroll
            for (int m = 0; m < 4; ++m)
#pragma unroll
                for (int bj = 0; bj < 2; ++bj) gv[ai][m][bj] = *(const u32x2*)(g2 + (size_t)(row0 + ai * HALF + m * 16) * DM + u.pn * BM + bj * HALF + wc * 32 + 8 * fq);
#pragma unroll
        for (int ai = 0; ai < 2; ++ai)
#pragma unroll
            for (int m = 0; m < 4; ++m) { const int r = row0 + ai * HALF + m * 16;
#pragma unroll
                for (int bj = 0; bj < 2; ++bj) { const size_t o = (size_t)r * DM + u.pn * BM + bj * HALF + wc * 32 + 8 * fq;
                    f32x4 v0 = acc[ai][bj][m][0], v1 = acc[ai][bj][m][1];
#pragma unroll
                    for (int i = 0; i < 4; ++i) { v0[i] *= (float)((gv[ai][m][bj].x >> (8 * i)) & 255u) * (1.f / 255.f); v1[i] *= (float)((gv[ai][m][bj].y >> (8 * i)) & 255u) * (1.f / 255.f); }
                    *(u32x4*)(out + o) = pack8(v0, v1); } }
    }
};

struct BranchOrder {
    StaticOrder base;
    __host__ __device__ void init(int M, int N, int G_, int c_) { base.init(M, N, G_, c_); }
    __host__ __device__ bool next(int i, Unit& u) const { if (!base.next(i >> 2, u)) return false; u.ko = 512 * (i & 3); return true; }
};
struct Epi2b {
    static constexpr bool PERM = true, HOOK = false; static constexpr int H1 = -1, H2 = -1;
    const bf16_t* gates; bf16_t* out;
    __device__ __forceinline__ void operator()(const Acc& acc, const Unit& u, int wr, int wc, int fr, int fq) const {
        const int row0 = u.pm * BM + wr * 64 + fr, sl = u.ko >> 9; const bf16_t* gp = gates + (size_t)(sl < 2 ? sl : 2) * T * DM;
#pragma unroll
        for (int ai = 0; ai < 2; ++ai) {
            bf16x8 gv[4][2], pv[4][2];
#pragma unroll
            for (int m = 0; m < 4; ++m)
#pragma unroll
                for (int bj = 0; bj < 2; ++bj) { const size_t o = (size_t)(row0 + ai * HALF + m * 16) * DM + u.pn * BM + bj * HALF + wc * 32 + 8 * fq;
                    gv[m][bj] = *(const bf16x8*)(gp + o); if (sl) pv[m][bj] = *(const bf16x8*)(out + o); }
#pragma unroll
            for (int m = 0; m < 4; ++m)
#pragma unroll
                for (int bj = 0; bj < 2; ++bj) { const size_t o = (size_t)(row0 + ai * HALF + m * 16) * DM + u.pn * BM + bj * HALF + wc * 32 + 8 * fq;
                    f32x4 v0 = acc[ai][bj][m][0], v1 = acc[ai][bj][m][1];
#pragma unroll
                    for (int i = 0; i < 4; ++i) { v0[i] *= bf2f((bf16_t)gv[m][bj][i]); v1[i] *= bf2f((bf16_t)gv[m][bj][4 + i]); }
                    if (sl) {
#pragma unroll
                        for (int i = 0; i < 4; ++i) { v0[i] += bf2f((bf16_t)pv[m][bj][i]); v1[i] += bf2f((bf16_t)pv[m][bj][4 + i]); } }
                    *(u32x4*)(out + o) = pack8(v0, v1); }
            __builtin_amdgcn_sched_barrier(0);
        }
    }
};

struct EpiF32 {
    static constexpr bool PERM = false, HOOK = false; static constexpr int H1 = -1, H2 = -1;
    float* C; int ldc; int pad;
    __device__ __forceinline__ void operator()(const Acc& acc, const Unit& u, int wr, int wc, int fr, int fq) const {
        const int row0 = u.pm * BM + wr * 64 + fr, col0 = u.pn * BM + wc * 32 + 4 * fq;
#pragma unroll
        for (int ai = 0; ai < 2; ++ai)
#pragma unroll
            for (int m = 0; m < 4; ++m) { float* rowp = C + (size_t)(row0 + ai * HALF + m * 16) * ldc + col0;
#pragma unroll
                for (int bj = 0; bj < 2; ++bj)
#pragma unroll
                    for (int n = 0; n < 2; ++n) *(f32x4*)(rowp + bj * HALF + n * 16) = acc[ai][bj][m][n]; }
    }
};

struct EpiBf16P {
    static constexpr bool PERM = true, HOOK = false; static constexpr int H1 = -1, H2 = -1;
    bf16_t* C; int ldc; int pad;
    __device__ __forceinline__ void operator()(const Acc& acc, const Unit& u, int wr, int wc, int fr, int fq) const {
        const int row0 = u.pm * BM + wr * 64 + fr, col0 = u.pn * BM + wc * 32 + 8 * fq;
#pragma unroll
        for (int ai = 0; ai < 2; ++ai)
#pragma unroll
            for (int m = 0; m < 4; ++m) { bf16_t* rowp = C + (size_t)(row0 + ai * HALF + m * 16) * ldc + col0;
#pragma unroll
                for (int bj = 0; bj < 2; ++bj) *(u32x4*)(rowp + bj * HALF) = pack8(acc[ai][bj][m][0], acc[ai][bj][m][1]); }
    }
};

struct EpiSwiGLU {
    static constexpr bool PERM = true, HOOK = false; static constexpr int H1 = -1, H2 = -1;
    bf16_t* hid; const float* rstd;
    __device__ __forceinline__ void operator()(const Acc& acc, const Unit& u, int wr, int wc, int fr, int fq) const {
        const int row0 = u.pm * BM + wr * 64 + fr;
#pragma unroll
        for (int ai = 0; ai < 2; ++ai)
#pragma unroll
            for (int m = 0; m < 4; ++m) { const int r = row0 + ai * HALF + m * 16;
#pragma unroll
                for (int bj = 0; bj < 2; ++bj) { const f32x4 gt = acc[ai][bj][m][0], up = acc[ai][bj][m][1]; float h[4];
#pragma unroll
                    for (int i = 0; i < 4; ++i) h[i] = gt[i] * sigmoidf_(gt[i]) * up[i];
                    u32x2 w; w.x = cvt_pk_bf16(h[0], h[1]); w.y = cvt_pk_bf16(h[2], h[3]);
                    *(u32x2*)(hid + (size_t)r * DFF + u.pn * 128 + bj * 64 + wc * 16 + 4 * fq) = w; } }
    }
};

struct EpiC1 {
    static constexpr bool PERM = true, HOOK = false; static constexpr int H1 = -1, H2 = -1;
    bf16_t* h1; const float* posb;
    __device__ __forceinline__ void operator()(const Acc& acc, const Unit& u, int wr, int wc, int fr, int fq) const {
        const int row0 = u.pm * BM + wr * 64 + fr;
#pragma unroll
        for (int ai = 0; ai < 2; ++ai)
#pragma unroll
            for (int m = 0; m < 4; ++m) { const int r = row0 + ai * HALF + m * 16;
#pragma unroll
                for (int bj = 0; bj < 2; ++bj) { const int col = bj * HALF + wc * 32 + 8 * fq; const float* pb = posb + u.pn * 256 + col;
                    f32x4 v0 = acc[ai][bj][m][0], v1 = acc[ai][bj][m][1];
#pragma unroll
                    for (int i = 0; i < 4; ++i) { const float a = v0[i] + pb[i], b = v1[i] + pb[4 + i]; v0[i] = a * sigmoidf_(a); v1[i] = b * sigmoidf_(b); }
                    *(u32x4*)(h1 + (size_t)r * 256 + col) = pack8(v0, v1); } }
    }
};
}


__device__ __forceinline__ int colmap(int mode, int n) {
    if (mode == 0) return n;
    if (mode == 1) {
        if (n < 1536) return n;
        if (n < 5632) return n + 4;
        const int j = n - 5632;
        if (j < 4) return 1536 + j;
        if (j < 28) return 5636 + (j - 4);
        return -1;
    }
    const int q = n >> 3, i = n & 7;
    return i < 4 ? 4 * q + i : DFF + 4 * q + (i - 4);
}

namespace att {
constexpr int KT = 16384, VT = 16384, KAT = 1024, STG = KT + VT + KAT;
constexpr int L_X3 = 3 * STG, L_X2 = 2 * STG;
constexpr int LDS_ATT_TOTAL = 147456;
constexpr int L_SLOT = LDS_ATT_TOTAL - 64, L_T0S = LDS_ATT_TOTAL - 96, L_BARW = LDS_ATT_TOTAL - 32;
constexpr float LOG2E = 1.4426950408889634f;
constexpr float NEG_INF = -__builtin_inff();
__device__ __forceinline__ int crow(int i, int hi) { return (i & 3) + 8 * (i >> 2) + 4 * hi; }

struct DmaOff { unsigned k[2], v[2]; };
__device__ __forceinline__ DmaOff dma_offsets(int wv, int lane) {
    DmaOff d;
#pragma unroll
    for (int ii = 0; ii < 2; ++ii) { const int row = 4 * (2 * wv + ii) + (lane >> 4), p = lane & 15;
        d.k[ii] = (unsigned)(row * 128 + ((p ^ (row & 15)) << 3)); d.v[ii] = (unsigned)(row * 128 + ((p ^ ((row & 3) << 2)) << 3)); }
    return d;
}
__device__ __forceinline__ void dma_tile(LAS unsigned char* sbase, const bf16_t* Kg, const bf16_t* Vg, int key0, const DmaOff& d, int wv) {
#pragma unroll
    for (int ii = 0; ii < 2; ++ii) {
        __builtin_amdgcn_global_load_lds((const unsigned*)(Kg + (size_t)key0 * HD + d.k[ii]), (LAS unsigned*)(sbase + (2 * wv + ii) * 1024), 16, 0, 0);
        __builtin_amdgcn_global_load_lds((const unsigned*)(Vg + (size_t)key0 * HD + d.v[ii]), (LAS unsigned*)(sbase + KT + (2 * wv + ii) * 1024), 16, 0, 0); }
}
__device__ __forceinline__ int kaddr(int lane, int c) { return (lane & 31) * 256 + ((c ^ (lane & 15)) << 4); }
__device__ __forceinline__ int vaddr(int lane, int dblk) { const int q = (lane >> 2) & 3;
    return (4 * (lane >> 5) + q) * 256 + ((dblk ^ q) << 6) + (((lane >> 4) & 1) << 5) + (((lane & 3) >> 1) << 4) + ((lane & 1) << 3); }
__device__ __forceinline__ unsigned pack_hilo(float x) { const float h = __uint_as_float(cvt_pk_bf16(x, 0.f) << 16); return cvt_pk_bf16(h, x - h); }
__device__ __forceinline__ bf16x8 make_qaug(float a0, float a1, int hi) {
    u32x4 w = {pack_hilo(a0), pack_hilo(a1), 0u, 0u}; if (hi) w = (u32x4){0u, 0u, 0u, 0u};
    return *reinterpret_cast<bf16x8*>(&w);
}
__device__ __forceinline__ void load_q(bf16x8* qf, const bf16_t* qrow, int hi) {
#pragma unroll
    for (int s = 0; s < 8; ++s) qf[s] = *(const bf16x8*)(qrow + 16 * s + 8 * hi);
}
template <int NS, bool AUG>
__device__ __forceinline__ void qk_tile(f32x16& p0, f32x16& p1, const LAS unsigned char* sb, const int* ka, int kaa, const bf16x8* qf, const bf16x8 qaug) {
#pragma unroll
    for (int i = 0; i < 16; ++i) { p0[i] = 0.f; p1[i] = 0.f; }
    constexpr int NG = NS / 2;
    bf16x8 kf[2][4];
#define QK_LOAD(g, par) do { kf[par][0] = *(const LAS bf16x8*)(sb + ka[2 * (g)]); kf[par][1] = *(const LAS bf16x8*)(sb + ka[2 * (g)] + 8192); \
        kf[par][2] = *(const LAS bf16x8*)(sb + ka[2 * (g) + 1]); kf[par][3] = *(const LAS bf16x8*)(sb + ka[2 * (g) + 1] + 8192); } while (0)
    QK_LOAD(0, 0);
#pragma unroll
    for (int g = 0; g < NG; ++g) {
        if (g + 1 < NG) QK_LOAD(g + 1, (g + 1) & 1);
        p0 = __builtin_amdgcn_mfma_f32_32x32x16_bf16(kf[g & 1][0], qf[2 * g], p0, 0, 0, 0);
        p1 = __builtin_amdgcn_mfma_f32_32x32x16_bf16(kf[g & 1][1], qf[2 * g], p1, 0, 0, 0);
        p0 = __builtin_amdgcn_mfma_f32_32x32x16_bf16(kf[g & 1][2], qf[2 * g + 1], p0, 0, 0, 0);
        p1 = __builtin_amdgcn_mfma_f32_32x32x16_bf16(kf[g & 1][3], qf[2 * g + 1], p1, 0, 0, 0);
        __builtin_amdgcn_sched_barrier(0);
    }
    if (AUG) {
        const bf16x8 a0 = *(const LAS bf16x8*)(sb + KT + VT + kaa), a1 = *(const LAS bf16x8*)(sb + KT + VT + kaa + 512);
        p0 = __builtin_amdgcn_mfma_f32_32x32x16_bf16(a0, qaug, p0, 0, 0, 0);
        p1 = __builtin_amdgcn_mfma_f32_32x32x16_bf16(a1, qaug, p1, 0, 0, 0);
    }
#undef QK_LOAD
}
__device__ __forceinline__ void softmax_step(f32x16& p0, f32x16& p1, float& m, float& l, f32x16* o, const float sc2) {
    float mx = fmaxf(p0[0], p1[0]);
#pragma unroll
    for (int i = 1; i < 16; ++i) mx = fmaxf(mx, fmaxf(p0[i], p1[i]));
    { auto rr = __builtin_amdgcn_permlane32_swap(__float_as_uint(mx), __float_as_uint(mx), false, false); mx = fmaxf(__uint_as_float(rr[0]), __uint_as_float(rr[1])); }
    constexpr float THR2 = 11.0f;
    if (!__all((mx - m) * sc2 <= THR2)) { const float mn = fmaxf(m, mx); const float alpha = __builtin_amdgcn_exp2f((m - mn) * sc2); l *= alpha;
#pragma unroll
        for (int d = 0; d < 4; ++d)
#pragma unroll
            for (int i = 0; i < 16; ++i) o[d][i] *= alpha;
        m = mn; }
    const float nm = -m * sc2;
    float ps = 0.f;
#pragma unroll
    for (int i = 0; i < 16; ++i) { p0[i] = __builtin_amdgcn_exp2f(fmaf(p0[i], sc2, nm)); p1[i] = __builtin_amdgcn_exp2f(fmaf(p1[i], sc2, nm)); ps += p0[i] + p1[i]; }
    l += ps;
}
__device__ __forceinline__ bf16x8 pfrag(const f32x16& p, int s) {
    u32x4 w; w.x = cvt_pk_bf16(p[8 * s + 0], p[8 * s + 1]); w.y = cvt_pk_bf16(p[8 * s + 2], p[8 * s + 3]); w.z = cvt_pk_bf16(p[8 * s + 4], p[8 * s + 5]); w.w = cvt_pk_bf16(p[8 * s + 6], p[8 * s + 7]);
    return *reinterpret_cast<bf16x8*>(&w);
}
__device__ __forceinline__ void pv_tile(f32x16* o, const LAS unsigned char* sb, const int* va, const f32x16& p0, const f32x16& p1) {
    bf16x8 pf[4]; pf[0] = pfrag(p0, 0); pf[1] = pfrag(p0, 1); pf[2] = pfrag(p1, 0); pf[3] = pfrag(p1, 1);
    s16x4 vl[2][4], vh[2][4];
#define PV_LOAD(d, par) do { _Pragma("unroll") for (int ks = 0; ks < 4; ++ks) { const LAS unsigned char* a_ = sb + KT + va[d] + 4096 * ks; \
        vl[par][ks] = __builtin_amdgcn_ds_read_tr16_b64_v4i16((LAS s16x4*)a_); vh[par][ks] = __builtin_amdgcn_ds_read_tr16_b64_v4i16((LAS s16x4*)(a_ + 2048)); } } while (0)
    PV_LOAD(0, 0);
#pragma unroll
    for (int d = 0; d < 4; ++d) {
        if (d + 1 < 4) PV_LOAD(d + 1, (d + 1) & 1);
#pragma unroll
        for (int ks = 0; ks < 4; ++ks) {
            const s16x4 lo = vl[d & 1][ks], hh = vh[d & 1][ks];
            const bf16x8 vf = {lo[0], lo[1], lo[2], lo[3], hh[0], hh[1], hh[2], hh[3]};
            o[d] = __builtin_amdgcn_mfma_f32_32x32x16_bf16(vf, pf[ks], o[d], 0, 0, 0);
        }
        __builtin_amdgcn_sched_barrier(0);
    }
#undef PV_LOAD
}
__device__ __forceinline__ float half_sum(float v) { auto rr = __builtin_amdgcn_permlane32_swap(__float_as_uint(v), __float_as_uint(v), false, false); return __uint_as_float(rr[0]) + __uint_as_float(rr[1]); }

__device__ __forceinline__ int queue_next(unsigned* ctr, LAS int* slot, const int wv) {
    __syncthreads();
    if (TID_OPAQUE(wv) == 0) { unsigned long long ca = (unsigned long long)ctr; asm volatile("" : "+s"(ca));
        *slot = (int)__hip_atomic_fetch_add((unsigned*)ca, 1u, __ATOMIC_RELAXED, __HIP_MEMORY_SCOPE_AGENT); }
    __syncthreads();
    return *slot;
}

template <int NSTG, bool CUM, class KF, class DJF, class BODY>
__device__ __forceinline__ void tile_loop(int NT, LAS unsigned char* lds, const bf16_t* Kg, const bf16_t* Vg, const float* cm, int tid, int wv, const KF& kf, const DJF& djf, const BODY& body) {
    const int lane = tid & 63;
    const DmaOff dof = dma_offsets(wv, lane);
#define TL_ISSUE(i, stg) do { const int i_ = (i) < NT ? (i) : NT - 1; const int k0_ = kf(i_); LAS unsigned char* sb_ = lds + (stg) * STG; dma_tile(sb_, Kg, Vg, k0_, dof, wv); \
        if (CUM) { if (wv == 0) __builtin_amdgcn_global_load_lds((const unsigned*)(cm + k0_ + lane), (LAS unsigned*)(sb_ + KT + VT), 4, 0, 0); } \
        else if (tid < 64) { const float fr_ = (float)tid, dj_ = djf(i_); *(LAS u32x4*)(sb_ + KT + VT + tid * 16) = (u32x4){cvt_pk_bf16(fr_, fr_), cvt_pk_bf16(dj_, dj_), 0u, 0u}; } } while (0)
#define TL_WAIT() do { if (NSTG == 3) asm volatile("s_waitcnt vmcnt(4) lgkmcnt(0)" ::: "memory"); else asm volatile("s_waitcnt vmcnt(0) lgkmcnt(0)" ::: "memory"); \
        __builtin_amdgcn_s_barrier(); asm volatile("" ::: "memory"); } while (0)
    TL_ISSUE(0, 0);
    if (NSTG == 3) TL_ISSUE(1, 1);
    TL_WAIT();
    if (NSTG == 3) {
        for (int t = 0; t < NT; t += 3) {
            TL_ISSUE(t + 2, 2); body(t, lds); TL_WAIT();
            if (t + 1 >= NT) break;
            TL_ISSUE(t + 3, 0); body(t + 1, lds + STG); TL_WAIT();
            if (t + 2 >= NT) break;
            TL_ISSUE(t + 4, 1); body(t + 2, lds + 2 * STG); TL_WAIT();
        }
    } else {
        for (int t = 0; t < NT; t += 2) {
            TL_ISSUE(t + 1, 1); body(t, lds); TL_WAIT();
            if (t + 1 >= NT) break;
            TL_ISSUE(t + 2, 0); body(t + 1, lds + STG); TL_WAIT();
        }
    }
    asm volatile("s_waitcnt vmcnt(0)" ::: "memory"); __builtin_amdgcn_s_barrier(); asm volatile("" ::: "memory");
#undef TL_ISSUE
#undef TL_WAIT
}

__device__ __forceinline__ void fox_item(int bh, int xb, LAS unsigned char* lds, const bf16_t* qkv, const float* cum, bf16_t* attb, const int wv) {
    const int tid = TID_OPAQUE(wv);
    const int wid = wv, lane = tid & 63, r32 = lane & 31, hi = lane >> 5;
    const int b = bh >> 2, h = bh & 3, q0 = xb * 256, qw = q0 + 32 * wid, qi = qw + r32;
    const bf16_t* Qg = qkv + ((size_t)((SL_FQ + h) * 4 + b) * SEQ) * HD; const bf16_t* Kg = qkv + ((size_t)((SL_FK + h) * 4 + b) * SEQ) * HD; const bf16_t* Vg = qkv + ((size_t)((SL_FV + h) * 4 + b) * SEQ) * HD;
    const float* cm = cum + (size_t)bh * SEQ;
    bf16x8 qf[8]; load_q(qf, Qg + (size_t)qi * HD, hi);
    bf16x8 qaug; { u32x4 w = {0u, 0u, 0u, 0u}; qaug = *reinterpret_cast<bf16x8*>(&w); }
    const int NT = 4 * (xb + 1);
    int ka[8], va[4];
#pragma unroll
    for (int s = 0; s < 8; ++s) ka[s] = kaddr(lane, 2 * s + hi);
#pragma unroll
    for (int d = 0; d < 4; ++d) va[d] = vaddr(lane, d);
    f32x16 o[4];
#pragma unroll
    for (int d = 0; d < 4; ++d)
#pragma unroll
        for (int i = 0; i < 16; ++i) o[d][i] = 0.f;
    float m = -1e30f, l = 0.f;
    constexpr float SCN = 0.08838834764831845f, SC2 = SCN * LOG2E, CINV = 1.0f / SCN;
    const float cq0 = cm[q0];
    auto kf = [&](int i) { return 64 * i; };
    auto djf = [&](int) { return 0.f; };
    auto body = [&](int t, LAS unsigned char* sb) {
        const int key0 = 64 * t;
        if (key0 <= qw + 31) {
            f32x16 p0, p1;
            qk_tile<8, false>(p0, p1, sb, ka, 0, qf, qaug);
            const LAS float* cb = (const LAS float*)(sb + KT + VT);
#pragma unroll
            for (int g = 0; g < 4; ++g) {
                const f32x4 c0 = *(const LAS f32x4*)(cb + 8 * g + 4 * hi), c1 = *(const LAS f32x4*)(cb + 32 + 8 * g + 4 * hi);
#pragma unroll
                for (int e = 0; e < 4; ++e) { const int i = 4 * g + e; p0[i] = fmaf(cq0 - c0[e], CINV, p0[i]); p1[i] = fmaf(cq0 - c1[e], CINV, p1[i]); }
            }
            if (key0 + 63 > qw) {
                asm volatile("; masked tile: keep this a real branch (rare path)");
                const int dq = qi - key0 - 4 * hi;
#pragma unroll
                for (int i = 0; i < 16; ++i) { const int c = (i & 3) + 8 * (i >> 2); p0[i] = c > dq ? NEG_INF : p0[i]; p1[i] = c + 32 > dq ? NEG_INF : p1[i]; }
            }
            softmax_step(p0, p1, m, l, o, SC2);
            pv_tile(o, sb, va, p0, p1);
        }
    };
    tile_loop<3, true>(NT, lds, Kg, Vg, cm, tid, wv, kf, djf, body);
    const float inv = 1.0f / half_sum(l);
    bf16_t* orow = attb + ((size_t)(b * SEQ + qi)) * DM + h * HD;
#pragma unroll
    for (int d = 0; d < 4; ++d)
#pragma unroll
        for (int g = 0; g < 4; ++g) { u32x2 w; w.x = cvt_pk_bf16(o[d][4 * g] * inv, o[d][4 * g + 1] * inv); w.y = cvt_pk_bf16(o[d][4 * g + 2] * inv, o[d][4 * g + 3] * inv);
            *(u32x2*)(orow + 32 * d + 8 * g + 4 * hi) = w; }
}

__device__ __forceinline__ void diff_map_step(f32x16* o, float& m, float& l, const LAS unsigned char* sb, const int* ka, int kaa, const int* va, const bf16x8* qf, const bf16x8 qaug,
                                              bool needmask, int dq  ) {
    f32x16 p0, p1;
    qk_tile<4, true>(p0, p1, sb, ka, kaa, qf, qaug);
    if (needmask) {
        asm volatile("; masked tile: keep this a real branch (rare path)");
#pragma unroll
        for (int i = 0; i < 16; ++i) { const int c = (i & 3) + 8 * (i >> 2); p0[i] = c > dq ? NEG_INF : p0[i]; p1[i] = c + 32 > dq ? NEG_INF : p1[i]; } }
    softmax_step(p0, p1, m, l, o, 0.125f * LOG2E);
    pv_tile(o, sb, va, p0, p1);
}
constexpr int L_DX = 0;
__device__ __forceinline__ void diff_item(int bh, int xb, LAS unsigned char* lds, const bf16_t* qkv, const unsigned* kbound, const float* lamv, const float* subln, float lam_init, float oml, bf16_t* attb, const int wv) {
    const int tid = TID_OPAQUE(wv);
    const int wid = wv, lane = tid & 63, r32 = lane & 31, hi = lane >> 5, rw = wid & 3, mp = wid >> 2;
    const int b = bh >> 2, h = bh & 3, q0 = xb * 128, qw = q0 + 32 * rw, qi = qw + r32;
    const bf16_t* Qg = qkv + ((size_t)((SL_DQ + h) * 4 + b) * SEQ) * HD; const bf16_t* Kg = qkv + ((size_t)((SL_DK + h) * 4 + b) * SEQ) * HD; const bf16_t* Vg = qkv + ((size_t)((SL_DV + h) * 4 + b) * SEQ) * HD;
    bf16x8 qf[4];
#pragma unroll
    for (int s = 0; s < 4; ++s) qf[s] = *(const bf16x8*)(Qg + (size_t)qi * HD + 64 * mp + 16 * s + 8 * hi);
    const float a0 = exp2f(-2.0f * (float)(h + 1)) * 8.0f;
    const bf16x8 qaug = make_qaug(a0, 64.0f * a0, hi);
    const int NTall = 2 * (xb + 1), j0 = 2 * xb;
    int ka[4], va[4]; const int kaa = r32 * 16;
#pragma unroll
    for (int s = 0; s < 4; ++s) ka[s] = kaddr(lane, 2 * s + hi + 8 * mp);
#pragma unroll
    for (int d = 0; d < 4; ++d) va[d] = vaddr(lane, d);
    int t0w;
    { float qs = 0.f;
#pragma unroll
      for (int s = 0; s < 4; ++s)
#pragma unroll
          for (int e = 0; e < 8; ++e) { const float v = bf2f((bf16_t)qf[s][e]); qs = fmaf(v, v, qs); }
      qs = wave_max(half_sum(qs));
      float ks = 0.f;
#pragma unroll
      for (int pp = 0; pp < 8; ++pp) ks += __uint_as_float(kbound[(h * 4 + b) * 16 + 8 * mp + pp]);
      const float bound = 2.0f * sqrtf(qs * ks) * 1.02f * (0.125f * LOG2E);
      const float X = (36.0f + bound) / (exp2f(-2.0f * (float)(h + 1)) * LOG2E);
      const float v = ((float)(qw - 63) - X) * (1.0f / 64.0f);
      t0w = v > 0.f ? (int)ceilf(v) : 0; if (t0w > NTall - 1) t0w = NTall - 1; }
    LAS int* t0s = (LAS int*)(lds + L_T0S);
    if (tid == 0) *t0s = NTall;
    __syncthreads();
    if (lane == 0) __hip_atomic_fetch_min(t0s, t0w, __ATOMIC_RELAXED, __HIP_MEMORY_SCOPE_WORKGROUP);
    __syncthreads();
    const int t0 = *t0s, NT = NTall - t0;
    f32x16 o[4];
#pragma unroll
    for (int d = 0; d < 4; ++d)
#pragma unroll
        for (int i = 0; i < 16; ++i) o[d][i] = 0.f;
    float m = -1e30f, l = 0.f;
    auto kf = [&](int i) { return 64 * (i + t0); };
    auto djf = [&](int i) { return (float)(i + t0 - j0); };
    auto body = [&](int ti, LAS unsigned char* sb) {
        const int t = ti + t0, key0 = 64 * t;
        if (key0 <= qw + 31 && t >= t0w) {
            const bool needmask = key0 + 63 > qw; const int dq = qi - key0 - 4 * hi;
            diff_map_step(o, m, l, sb, ka, kaa, va, qf, qaug, needmask, dq);
        }
    };
    tile_loop<3, false>(NT, lds, Kg, Vg, (const float*)nullptr, tid, wv, kf, djf, body);
    const float la = wave_sum(lamv[lane] * lamv[64 + lane]), lb = wave_sum(lamv[128 + lane] * lamv[192 + lane]);
    const float lam = expf(la) - expf(lb) + lam_init;
    LAS float* xw = (LAS float*)(lds + L_DX) + rw * 4096 + lane;
    const float inv = (mp == 0 ? 1.0f : lam) / half_sum(l);
    if (mp == 1) {
#pragma unroll
        for (int d = 0; d < 4; ++d)
#pragma unroll
            for (int i = 0; i < 16; ++i) xw[(d * 16 + i) * 64] = o[d][i] * inv;
    }
    __syncthreads();
    if (mp == 0) {
        float ss = 0.f;
#pragma unroll
        for (int d = 0; d < 4; ++d)
#pragma unroll
            for (int i = 0; i < 16; ++i) { const float v = o[d][i] * inv - xw[(d * 16 + i) * 64]; o[d][i] = v; ss = fmaf(v, v, ss); if (i == 15) __builtin_amdgcn_sched_barrier(0); }
        ss = half_sum(ss);
        const float rn = rsqrtf(ss * (1.f / 128.f) + EPS) * oml;
        bf16_t* orow = attb + ((size_t)(b * SEQ + qi)) * DM + 512 + h * HD;
#pragma unroll
        for (int d = 0; d < 4; ++d)
#pragma unroll
            for (int g = 0; g < 4; ++g) { const f32x4 sg = *(const f32x4*)(subln + 32 * d + 8 * g + 4 * hi);
                u32x2 w; w.x = cvt_pk_bf16(o[d][4 * g] * rn * sg[0], o[d][4 * g + 1] * rn * sg[1]); w.y = cvt_pk_bf16(o[d][4 * g + 2] * rn * sg[2], o[d][4 * g + 3] * rn * sg[3]);
                *(u32x2*)(orow + 32 * d + 8 * g + 4 * hi) = w; if (g == 3) __builtin_amdgcn_sched_barrier(0); }
    }
}

constexpr int L_NS = L_X2 + 1024;
constexpr int L_SM = L_NS + 65536;
constexpr int L_UM = L_SM + 512;
constexpr int L_TL = L_UM + 128;
constexpr int L_SC = L_TL + 64;
constexpr int NSA_END = L_SC + 1024;
constexpr int L_V2 = 0;

__device__ __forceinline__ void softmax_stats(const f32x16& p0, const f32x16& p1, float& m, float& l, const float sc2) {
    float mx = fmaxf(p0[0], p1[0]);
#pragma unroll
    for (int i = 1; i < 16; ++i) mx = fmaxf(mx, fmaxf(p0[i], p1[i]));
    { auto rr = __builtin_amdgcn_permlane32_swap(__float_as_uint(mx), __float_as_uint(mx), false, false); mx = fmaxf(__uint_as_float(rr[0]), __uint_as_float(rr[1])); }
    const float mn = fmaxf(m, mx), nm = -mn * sc2;
    float ps = 0.f;
#pragma unroll
    for (int i = 0; i < 16; ++i) ps += __builtin_amdgcn_exp2f(fmaf(p0[i], sc2, nm)) + __builtin_amdgcn_exp2f(fmaf(p1[i], sc2, nm));
    l = l * __builtin_amdgcn_exp2f((m - mn) * sc2) + ps; m = mn;
}
__device__ __forceinline__ int ctz64(unsigned long long x) { return __builtin_ctzll(x); }

template <class XF, class POST>
__device__ __forceinline__ void nsa_branch(LAS unsigned char* lds, const bf16_t* Kg, const bf16_t* Vg, unsigned long long tiles, unsigned long long wact, int j0,
                                           const bf16x8* qf, const bf16x8 qaug, const int* ka, int kaa, const int* va, int tid, int wv, float gate, f32x16* o, const XF& xf, const POST& post) {
    if (tiles == 0ull) return;
    constexpr float SC2 = 0.08838834764831845f * LOG2E;
    LAS unsigned char* tl = lds + L_TL;
    if (tid == 0) { unsigned long long bits = tiles; int n = 0; while (bits) { tl[n++] = (unsigned char)ctz64(bits); bits &= bits - 1; } }
    const int NT = __builtin_popcountll(tiles);
    __syncthreads();
    float m = -1e30f, l = 0.f;
    auto kf = [&](int i) { return 64 * (int)tl[i]; };
    auto djf = [&](int i) { return (float)((int)tl[i] - j0); };
    auto bodyA = [&](int t, LAS unsigned char* sb) { const int j = (int)__builtin_amdgcn_readfirstlane((int)tl[t]);
        if ((wact >> j) & 1ull) { f32x16 p0, p1; qk_tile<8, true>(p0, p1, sb, ka, kaa, qf, qaug); xf(p0, p1, j); softmax_stats(p0, p1, m, l, SC2); } };
    tile_loop<2, false>(NT, lds, Kg, Vg, (const float*)nullptr, tid, wv, kf, djf, bodyA);
    const float lt = half_sum(l);
    const float scl = lt > 0.f ? 1.0f / lt : 0.f;
    const float nm = -m * SC2;
    auto bodyB = [&](int t, LAS unsigned char* sb) { const int j = (int)__builtin_amdgcn_readfirstlane((int)tl[t]);
        if ((wact >> j) & 1ull) { f32x16 p0, p1; qk_tile<8, true>(p0, p1, sb, ka, kaa, qf, qaug); xf(p0, p1, j);
#pragma unroll
            for (int i = 0; i < 16; ++i) { p0[i] = __builtin_amdgcn_exp2f(fmaf(p0[i], SC2, nm)) * scl; p1[i] = __builtin_amdgcn_exp2f(fmaf(p1[i], SC2, nm)) * scl; }
            post(p0, p1, j);
#pragma unroll
            for (int i = 0; i < 16; ++i) { p0[i] *= gate; p1[i] *= gate; }
            pv_tile(o, sb, va, p0, p1); } };
    tile_loop<2, false>(NT, lds, Kg, Vg, (const float*)nullptr, tid, wv, kf, djf, bodyB);
}

template <class XF, class POST>
__device__ __forceinline__ void nsa_branch_cmp(LAS unsigned char* lds, const bf16_t* Kg, const bf16_t* Vg, unsigned long long tiles, unsigned long long wact, int j0,
                                               const bf16x8* qf, const bf16x8 qaug, const int* ka, int kaa, const int* va, int tid, int wv, float gate, f32x16* o,
                                               LAS float* imprh, LAS float* sclw, const XF& xf, const POST& post) {
    constexpr float SC2 = 0.08838834764831845f * LOG2E;
    LAS unsigned char* tl = lds + L_TL;
    const int NT = __builtin_popcountll(tiles);
    if (tid == 0) { unsigned long long bits = tiles; int n = NT; while (bits) { tl[--n] = (unsigned char)ctz64(bits); bits &= bits - 1; } }
    __syncthreads();
    float m = -1e30f, l = 0.f;
    auto kf = [&](int i) { return 64 * (int)tl[i]; };
    auto djf = [&](int i) { return (float)((int)tl[i] - j0); };
    auto body = [&](int t, LAS unsigned char* sb) { const int j = (int)__builtin_amdgcn_readfirstlane((int)tl[t]);
        if ((wact >> j) & 1ull) { f32x16 p0, p1; qk_tile<8, true>(p0, p1, sb, ka, kaa, qf, qaug); xf(p0, p1, j);
            const float mold = m;
            softmax_step(p0, p1, m, l, o, SC2);
            if (__any(m != mold && mold > -1e29f)) { const float alpha = __builtin_amdgcn_exp2f((mold - m) * SC2);
#pragma unroll 8
                for (int i = 0; i < 32; ++i) imprh[i * 32] *= alpha; }
            post(p0, p1, j);
            pv_tile(o, sb, va, p0, p1); } };
    tile_loop<2, false>(NT, lds, Kg, Vg, (const float*)nullptr, tid, wv, kf, djf, body);
    const float lt = half_sum(l);
    const float scl = lt > 0.f ? 1.0f / lt : 0.f;
    if ((tid & 63) < 32) sclw[tid & 31] = scl;
    const float inv = gate * scl;
#pragma unroll
    for (int d = 0; d < 4; ++d)
#pragma unroll
        for (int i = 0; i < 16; ++i) o[d][i] *= inv;
}
template <class XF>
__device__ __forceinline__ void nsa_branch_online(LAS unsigned char* lds, const bf16_t* Kg, const bf16_t* Vg, unsigned long long tiles, unsigned long long wact, int j0,
                                                  const bf16x8* qf, const bf16x8 qaug, const int* ka, int kaa, const int* va, int tid, int wv, float gate, f32x16* o, const XF& xf) {
    constexpr float SC2 = 0.08838834764831845f * LOG2E;
    LAS unsigned char* tl = lds + L_TL;
    if (tid == 0) { unsigned long long bits = tiles; int n = 0; while (bits) { tl[n++] = (unsigned char)ctz64(bits); bits &= bits - 1; } }
    const int NT = __builtin_popcountll(tiles);
    __syncthreads();
    float m = -1e30f, l = 0.f;
    auto kf = [&](int i) { return 64 * (int)tl[i]; };
    auto djf = [&](int i) { return (float)((int)tl[i] - j0); };
    auto body = [&](int t, LAS unsigned char* sb) { const int j = (int)__builtin_amdgcn_readfirstlane((int)tl[t]);
        if ((wact >> j) & 1ull) { f32x16 p0, p1; qk_tile<8, true>(p0, p1, sb, ka, kaa, qf, qaug); xf(p0, p1, j);
            softmax_step(p0, p1, m, l, o, SC2); pv_tile(o, sb, va, p0, p1); } };
    tile_loop<2, false>(NT, lds, Kg, Vg, (const float*)nullptr, tid, wv, kf, djf, body);
    const float inv = gate / half_sum(l);
#pragma unroll
    for (int d = 0; d < 4; ++d)
#pragma unroll
        for (int i = 0; i < 16; ++i) o[d][i] *= inv;
}
__device__ __forceinline__ void park_store(LAS unsigned* slab, int lane, const f32x16* o) {
#pragma unroll
    for (int d = 0; d < 4; ++d)
#pragma unroll
        for (int i = 0; i < 8; ++i) slab[(d * 8 + i) * 64 + lane] = cvt_pk_bf16(o[d][2 * i], o[d][2 * i + 1]);
}
__device__ __forceinline__ void park_add(const LAS unsigned* slab, int lane, f32x16* o) {
#pragma unroll
    for (int d = 0; d < 4; ++d)
#pragma unroll
        for (int i = 0; i < 8; ++i) { const unsigned w = slab[(d * 8 + i) * 64 + lane]; o[d][2 * i] += __uint_as_float(w << 16); o[d][2 * i + 1] += __uint_as_float(w & 0xffff0000u); }
}

__device__ __forceinline__ void nsa_item(int bg, int xq, LAS unsigned char* lds, const bf16_t* qkv, const bf16_t* kvc, const float* nsag, const unsigned* kbound, bf16_t* attb, const int wv) {
    const int tid = TID_OPAQUE(wv);
    const int wid = wv, lane = tid & 63, r32 = lane & 31, hi = lane >> 5, hw = (wid >> 1) ^ ((wid >> 2) & 1), sub = wid & 1;
    const int b = bg >> 1, g = bg & 1, hh = g * 4 + hw, q0 = xq * 64, qw = q0 + 32 * sub, qi = qw + r32, cur = xq;
    const bf16_t* Qg = qkv + ((size_t)((SL_NQ + hh) * 4 + b) * SEQ) * HD;
    bf16x8 qf[8]; load_q(qf, Qg + (size_t)qi * HD, hi);
    const size_t tok = (size_t)b * SEQ + qi;
    const float g0 = nsag[tok * 24 + hh * 3 + 0], g1 = nsag[tok * 24 + hh * 3 + 1], g2 = nsag[tok * 24 + hh * 3 + 2];
    const float a0 = exp2f(-(float)(hh + 1)) * 11.313708498984761f;
    const bf16x8 qaug = make_qaug(a0, 64.0f * a0, hi), qaugc = make_qaug(16.0f * a0, 1024.0f * a0, hi);
    int ka[8], va[4]; const int kaa = r32 * 16;
#pragma unroll
    for (int s = 0; s < 8; ++s) ka[s] = kaddr(lane, 2 * s + hi);
#pragma unroll
    for (int d = 0; d < 4; ++d) va[d] = vaddr(lane, d);
    f32x16 o[4];
#pragma unroll
    for (int d = 0; d < 4; ++d)
#pragma unroll
        for (int i = 0; i < 16; ++i) o[d][i] = 0.f;
    LAS float* impw = (LAS float*)(lds + L_NS) + wid * 2048;
    LAS unsigned* selm = (LAS unsigned*)(lds + L_SM);
    LAS unsigned* um = (LAS unsigned*)(lds + L_UM);
#pragma unroll
    for (int i = 0; i < 32; ++i) impw[i * 64 + lane] = 0.f;
    LAS int* t0m = (LAS int*)(lds + L_T0S);
    if (wid == 0) { selm[lane] = 0u; selm[64 + lane] = 0u; if (lane < 18) um[lane] = 0u; if (lane < 2) t0m[lane] = 64; }
    __syncthreads();
    int t0sel, t0win;
    { float qs = 0.f;
#pragma unroll
      for (int s = 0; s < 8; ++s)
#pragma unroll
          for (int e = 0; e < 8; ++e) { const float v = bf2f((bf16_t)qf[s][e]); qs = fmaf(v, v, qs); }
      qs = wave_max(half_sum(qs));
      const unsigned* kb = kbound + 1024 + (g * 4 + b) * 16;
      float kss = 0.f, ksw = 0.f;
#pragma unroll
      for (int pp = 0; pp < 16; ++pp) { kss += __uint_as_float(kb[pp]); ksw += __uint_as_float(kb[128 + pp]); }
      const float c2 = 2.0f * 1.02f * (0.08838834764831845f * LOG2E), isl = 1.0f / (exp2f(-(float)(hh + 1)) * LOG2E);
      const float vs = ((float)(qw - 63) - (36.0f + c2 * sqrtf(qs * kss)) * isl) * (1.0f / 64.0f), vw = ((float)(qw - 63) - (36.0f + c2 * sqrtf(qs * ksw)) * isl) * (1.0f / 64.0f);
      int ts = vs > 0.f ? (int)ceilf(vs) : 0, tw = vw > 0.f ? (int)ceilf(vw) : 0;
      ts = ts > cur ? cur : ts; tw = tw > cur ? cur : tw;
      t0sel = __builtin_amdgcn_readfirstlane(ts); t0win = __builtin_amdgcn_readfirstlane(tw);
      if (lane == 0) { __hip_atomic_fetch_min(t0m, t0sel, __ATOMIC_RELAXED, __HIP_MEMORY_SCOPE_WORKGROUP); __hip_atomic_fetch_min(t0m + 1, t0win, __ATOMIC_RELAXED, __HIP_MEMORY_SCOPE_WORKGROUP); } }
    {
        const int cq = qi >= 31 ? (qi - 31) >> 4 : -1;
        const int cmax_w = (qw + 31 - 31) >> 4;
        const int ntc = ((4 * xq + 2) >> 6) + 1;
        const unsigned long long tiles = (1ull << ntc) - 1ull;
        const unsigned long long wact = (1ull << ((cmax_w >> 6) + 1)) - 1ull;
        const int cqmin = qw >= 31 ? (qw - 31) >> 4 : -1;
        auto xf = [&](f32x16& p0, f32x16& p1, int j) {
            if (64 * j + 63 > cqmin) {
                asm volatile("; masked tile: keep this a real branch (rare path)");
                const int c0 = 64 * j + 4 * hi;
#pragma unroll
                for (int i = 0; i < 16; ++i) { const int c = c0 + (i & 3) + 8 * (i >> 2); p0[i] = c > cq ? NEG_INF : p0[i]; p1[i] = c + 32 > cq ? NEG_INF : p1[i]; } }
        };
        auto post = [&](const f32x16& p0, const f32x16& p1, int j) {
            LAS float* cell = impw + (16 * j + hi) * 32 + r32;
            const int paddr = (lane ^ 32) << 2;
            float X[4][2];
#pragma unroll
            for (int gq = 0; gq < 4; ++gq) { X[gq][0] = __int_as_float(__builtin_amdgcn_ds_bpermute(paddr, __float_as_int(p0[4 * gq + 3]))); X[gq][1] = __int_as_float(__builtin_amdgcn_ds_bpermute(paddr, __float_as_int(p1[4 * gq + 3]))); }
#pragma unroll
            for (int kh = 0; kh < 2; ++kh)
#pragma unroll
                for (int gq = 0; gq < 4; ++gq) {
                    const float sum4 = kh ? ((p1[4 * gq] + p1[4 * gq + 1]) + p1[4 * gq + 2]) + p1[4 * gq + 3] : ((p0[4 * gq] + p0[4 * gq + 1]) + p0[4 * gq + 2]) + p0[4 * gq + 3];
                    const float prevlo = gq ? X[gq - 1][kh] : (kh ? X[3][0] : 0.f);
                    cell[(8 * kh + 2 * gq) * 32] = sum4 + (hi ? X[gq][kh] : prevlo);
                }
            if (hi && 16 * j + 16 < 64) cell[15 * 32] += p1[15];
        };
        nsa_branch_cmp(lds, kvc + (size_t)(g * 4 + b) * 256 * HD, kvc + (size_t)(8 + g * 4 + b) * 256 * HD, tiles, wact, ntc - 1, qf, qaugc, ka, kaa, va, tid, wv, g0, o,
                       impw + 1024 * hi + r32, (LAS float*)(lds + L_SC) + wid * 32, xf, post);
    }
    __syncthreads();
    {
        const int q = tid >> 3, jg = tid & 7;
        const LAS float* ib = (const LAS float*)(lds + L_NS) + (q >> 5) * 2048 + jg * 256 + (q & 31);
        LAS float* v2 = (LAS float*)(lds + L_V2) + q * 64;
        const LAS float* scq = (const LAS float*)(lds + L_SC) + (q >> 5) * 32 + (q & 31);
        const float sc0 = scq[0], sc1 = scq[64], sc2 = scq[128], sc3 = scq[192];
        unsigned kj[8];
        LAS unsigned* v2u = (LAS unsigned*)v2;
#pragma unroll
        for (int e = 0; e < 8; ++e) { const int j = jg * 8 + e;
            const float imp = ((ib[32 * e] * sc0 + ib[4096 + 32 * e] * sc1) + ib[8192 + 32 * e] * sc2) + ib[12288 + 32 * e] * sc3;
            const bool vs = j <= cur, forced = (j == 0) || (j == cur) || (j == cur - 1);
            kj[e] = vs ? ((__float_as_uint(forced ? 1e4f : imp) & ~63u) | (unsigned)(63 - j)) : 0u; v2u[jg * 8 + e] = kj[e]; }
        __syncthreads();
        int rank[8];
#pragma unroll
        for (int e = 0; e < 8; ++e) rank[e] = 0;
        for (int i = 0; i < 64; ++i) { const unsigned ki = v2u[i];
#pragma unroll
            for (int e = 0; e < 8; ++e) rank[e] += ki > kj[e] ? 1 : 0; }
        unsigned bits = 0u;
#pragma unroll
        for (int e = 0; e < 8; ++e) bits |= (rank[e] < 16 && jg * 8 + e <= cur) ? (1u << e) : 0u;
        bits <<= 8 * (jg & 3);
        __hip_atomic_fetch_or(selm + q * 2 + (jg >> 2), bits, __ATOMIC_RELAXED, __HIP_MEMORY_SCOPE_WORKGROUP);
        __hip_atomic_fetch_or(um + (jg >> 2), bits, __ATOMIC_RELAXED, __HIP_MEMORY_SCOPE_WORKGROUP);
        __hip_atomic_fetch_or(um + 2 + 2 * ((q >> 5) + 0) + (jg >> 2), bits, __ATOMIC_RELAXED, __HIP_MEMORY_SCOPE_WORKGROUP);
        __syncthreads();
    }
    const unsigned sm0 = selm[2 * (qi - q0)], sm1 = selm[2 * (qi - q0) + 1];
    const unsigned long long mysel = ((unsigned long long)sm1 << 32) | sm0;
    const unsigned long long utiles = ((unsigned long long)(unsigned)__builtin_amdgcn_readfirstlane((int)um[1]) << 32) | (unsigned)__builtin_amdgcn_readfirstlane((int)um[0]);
    const unsigned long long wtiles = ((unsigned long long)(unsigned)__builtin_amdgcn_readfirstlane((int)um[2 + 2 * sub + 1]) << 32) | (unsigned)__builtin_amdgcn_readfirstlane((int)um[2 + 2 * sub]);
    __syncthreads();
    {
        auto xf = [&](f32x16& p0, f32x16& p1, int j) {
            const bool mine = (mysel >> j) & 1ull; const int dq = qi - 64 * j - 4 * hi;
            if (j == cur || !__all(mine)) {
                asm volatile("; masked tile: keep this a real branch (rare path)");
#pragma unroll
                for (int i = 0; i < 16; ++i) { const int c = (i & 3) + 8 * (i >> 2); p0[i] = (!mine || c > dq) ? NEG_INF : p0[i]; p1[i] = (!mine || c + 32 > dq) ? NEG_INF : p1[i]; } }
        };
        LAS unsigned* slab = (LAS unsigned*)(lds + L_NS) + wid * 2048;
        park_store(slab, lane, o);
#pragma unroll
        for (int d = 0; d < 4; ++d)
#pragma unroll
            for (int i = 0; i < 16; ++i) o[d][i] = 0.f;
        const int t0a = __builtin_amdgcn_readfirstlane(t0m[0]);
        nsa_branch_online(lds, qkv + ((size_t)((SL_NKS + g) * 4 + b) * SEQ) * HD, qkv + ((size_t)((SL_NVS + g) * 4 + b) * SEQ) * HD, utiles & (~0ull << t0a), wtiles & (~0ull << t0sel), cur, qf, qaug, ka, kaa, va, tid, wv, g1, o, xf);
        park_add(slab, lane, o); park_store(slab, lane, o);
#pragma unroll
        for (int d = 0; d < 4; ++d)
#pragma unroll
            for (int i = 0; i < 16; ++i) o[d][i] = 0.f;
    }
    {
        const int jlo = cur - 8 > 0 ? cur - 8 : 0;
        const unsigned long long tiles = (cur == 63 ? ~0ull : ((1ull << (cur + 1)) - 1ull)) & ~((1ull << jlo) - 1ull);
        auto xf = [&](f32x16& p0, f32x16& p1, int j) {
            const int dq = qi - 64 * j - 4 * hi;
            if (j == cur || j == cur - 8) {
                asm volatile("; masked tile: keep this a real branch (rare path)");
#pragma unroll
                for (int i = 0; i < 16; ++i) { const int c = (i & 3) + 8 * (i >> 2); p0[i] = (unsigned)(dq - c) >= 512u ? NEG_INF : p0[i]; p1[i] = (unsigned)(dq - c - 32) >= 512u ? NEG_INF : p1[i]; } }
        };
        const int t0a = __builtin_amdgcn_readfirstlane(t0m[1]);
        nsa_branch_online(lds, qkv + ((size_t)((SL_NKW + g) * 4 + b) * SEQ) * HD, qkv + ((size_t)((SL_NVW + g) * 4 + b) * SEQ) * HD, tiles & (~0ull << t0a), tiles & (~0ull << t0win), cur, qf, qaug, ka, kaa, va, tid, wv, g2, o, xf);
        park_add((const LAS unsigned*)(lds + L_NS) + wid * 2048, lane, o);
    }
    bf16_t* orow = attb + tok * DM + 1024 + hh * HD;
#pragma unroll
    for (int d = 0; d < 4; ++d)
#pragma unroll
        for (int gq = 0; gq < 4; ++gq) { u32x2 w; w.x = cvt_pk_bf16(o[d][4 * gq], o[d][4 * gq + 1]); w.y = cvt_pk_bf16(o[d][4 * gq + 2], o[d][4 * gq + 3]);
            *(u32x2*)(orow + 32 * d + 8 * gq + 4 * hi) = w; }
}
}

#define XB_TMO      128
#define XB_XCNT(j)  (256  + 64 * (j))
#define XB_XSUB(j)  (1280 + 64 * (j))
#define XB_XGEN(j)  (2304 + 64 * (j))
#define XB_TOP      3328
#define XB_TOPGEN   3392
#define XCD_BAR_WORDS 3456
#define XB_SPIN_CAP (1u << 22)

__device__ __forceinline__ unsigned xb_ld(unsigned* p)              { return __hip_atomic_load(p, __ATOMIC_RELAXED, __HIP_MEMORY_SCOPE_AGENT); }
__device__ __forceinline__ unsigned xb_add(unsigned* p, unsigned v) { return __hip_atomic_fetch_add(p, v, __ATOMIC_RELAXED, __HIP_MEMORY_SCOPE_AGENT); }
__device__ __forceinline__ unsigned xb_xcc_id() { return (unsigned)__builtin_amdgcn_s_getreg((3 << 11) | 20) & 0xFu; }
#define XB_SPIN(cond, bar) do { unsigned _sp = 0; while (cond) { __builtin_amdgcn_s_sleep(1); \
    if ((++_sp & 255u) == 0u) { if (xb_ld(&(bar)[XB_TMO])) break; if (_sp > XB_SPIN_CAP) { atomicAdd(&(bar)[XB_TMO], 1u); break; } } } } while (0)

struct XcdBarrier { unsigned* bar; volatile LAS unsigned* st; };

__device__ __forceinline__ XcdBarrier xcd_barrier_post(unsigned* bar, volatile LAS unsigned* st, const int wv) {
    XcdBarrier b; b.bar = bar; b.st = st;
    if (TID_OPAQUE(wv) == 0) { const unsigned x = xb_xcc_id(); st[2] = x; (void)xb_add(&bar[XB_XCNT(x)], 1u); }
    return b;
}
__device__ __forceinline__ void xcd_barrier_complete(unsigned* bar, unsigned x, unsigned& nloc, unsigned& nx) {
    const unsigned G = gridDim.x * gridDim.y * gridDim.z;
    unsigned sum, cnt, mine, sp = 0u;
    for (;;) {
        sum = 0u; cnt = 0u; mine = 0u;
#pragma unroll
        for (unsigned j = 0; j < 16; ++j) { const unsigned c = xb_ld(&bar[XB_XCNT(j)]); sum += c; cnt += (c > 0u) ? 1u : 0u; mine = (j == x) ? c : mine; }
        if (sum == G) break;
        __builtin_amdgcn_s_sleep(1);
        if ((++sp & 255u) == 0u) { if (xb_ld(&bar[XB_TMO])) break; if (sp > XB_SPIN_CAP) { atomicAdd(&bar[XB_TMO], 1u); break; } }
    }
    nloc = mine > 0u ? mine : 1u; nx = cnt > 0u ? cnt : 1u;
}
__device__ __forceinline__ void xcd_barrier(const XcdBarrier& b, const int wv) {
    asm volatile("s_waitcnt vmcnt(0)" ::: "memory");
    __syncthreads();
    if (TID_OPAQUE(wv) == 0) {
        unsigned* bar = b.bar;
        __builtin_amdgcn_s_waitcnt(0);
        unsigned nloc = b.st[0], nx = b.st[1]; const unsigned bx = b.st[2];
        if (nloc == 0u) { xcd_barrier_complete(bar, bx, nloc, nx); b.st[0] = nloc; b.st[1] = nx; }
        const unsigned old = xb_add(&bar[XB_XSUB(bx)], 1u);
        const unsigned gen = old / nloc;
        if (old + 1u == (gen + 1u) * nloc) {
            __builtin_amdgcn_fence(__ATOMIC_RELEASE, "agent");
            asm volatile("s_waitcnt vmcnt(0)" ::: "memory");
            const unsigned og = xb_add(&bar[XB_TOP], 1u);
            const unsigned tg = og / nx;
            if (og + 1u == (tg + 1u) * nx) xb_add(&bar[XB_TOPGEN], 1u);
            else XB_SPIN(xb_ld(&bar[XB_TOPGEN]) == tg, bar);
            __builtin_amdgcn_fence(__ATOMIC_ACQUIRE, "agent");
            xb_add(&bar[XB_XGEN(bx)], 1u);
            asm volatile("s_waitcnt vmcnt(0)" ::: "memory");
        } else {
            XB_SPIN(xb_ld(&bar[XB_XGEN(bx)]) == gen, bar);
            __builtin_amdgcn_fence(__ATOMIC_ACQUIRE, "agent");
            asm volatile("s_waitcnt vmcnt(0)" ::: "memory");
        }
    }
    __syncthreads();
}

struct Params {
    const float* x_in; const float* w_in; const float* fbias; const float* dlam; const float* subln; const float* cpos; const float* cw1; const float* cw2;
    const float* wbf; const float* wbd; const float* wbn; const float* wgate; const float* wout; const float* gains; const float* wup; const float* wdn;
    float* xo; unsigned char* ws;
};
constexpr int LDS_GEMM = pg8::STAGE_BYTES;
constexpr int LDS_BARW = att::L_BARW;
constexpr int LDS_TOTAL = att::LDS_ATT_TOTAL;
static_assert(att::NSA_END <= att::L_T0S && att::L_X3 + 1024 <= att::L_T0S && LDS_GEMM <= att::L_T0S && att::L_DX + 65536 <= att::L_T0S, "LDS map");

typedef const __attribute__((address_space(4))) Params* KParams;
struct CvtJob { const float* src; bf16_t* dst; const float* gain; int K, Nsrc, ldd, nrows, mode, pad; };
__device__ __forceinline__ CvtJob cvt_job(KParams p, int l, int j) {
    bf16_t* W = (bf16_t*)(p->ws + WS_W) + (size_t)l * LW_EL; CvtJob J{};
    switch (j) {
        case 0: J.src = p->w_in + (size_t)l * DM * IN_COLS; J.dst = W + OFF_W1T; J.K = DM; J.Nsrc = IN_COLS; J.ldd = DM; J.nrows = 5888; J.mode = 1; J.gain = p->gains + (size_t)(l * 4 + 0) * DM; break;
        case 1: J.src = p->wgate + (size_t)l * DM * 6144; J.dst = W + OFF_W1T + (size_t)5888 * DM; J.K = DM; J.Nsrc = 6144; J.ldd = DM; J.nrows = 6144; J.mode = 0; J.gain = p->gains + (size_t)(l * 4 + 0) * DM; break;
        case 2: J.src = p->wbf + (size_t)l * 512 * DM; J.dst = W + OFF_WBT; J.K = 512; J.Nsrc = DM; J.ldd = DM; J.nrows = DM; J.mode = 0; break;
        case 3: J.src = p->wbd + (size_t)l * 512 * DM; J.dst = W + OFF_WBT + 512; J.K = 512; J.Nsrc = DM; J.ldd = DM; J.nrows = DM; J.mode = 0; break;
        case 4: J.src = p->wbn + (size_t)l * 1024 * DM; J.dst = W + OFF_WBT + 1024; J.K = 1024; J.Nsrc = DM; J.ldd = DM; J.nrows = DM; J.mode = 0; break;
        case 5: J.src = p->wout + (size_t)l * DM * DM; J.dst = W + OFF_WOT; J.K = DM; J.Nsrc = DM; J.ldd = DM; J.nrows = DM; J.mode = 0; break;
        case 6: J.src = p->wup + (size_t)l * DM * 2 * DFF; J.dst = W + OFF_WUP; J.K = DM; J.Nsrc = 2 * DFF; J.ldd = DM; J.nrows = 2 * DFF; J.mode = 2; J.gain = p->gains + (size_t)(l * 4 + 2) * DM; break;
        case 7: J.src = p->wdn + (size_t)l * DFF * DM; J.dst = W + OFF_WDN; J.K = DFF; J.Nsrc = DM; J.ldd = DFF; J.nrows = DM; J.mode = 0; break;
        case 8: J.src = p->cw1 + ((size_t)l * 2 + 0) * 4096 * 256; J.dst = W + OFF_WC1; J.K = 4096; J.Nsrc = 256; J.ldd = 4096; J.nrows = 256; J.mode = 0; break;
        case 10: J.src = p->cw2 + ((size_t)l * 2 + 0) * 256 * 128; J.dst = W + OFF_WC2; J.K = 256; J.Nsrc = 128; J.ldd = 256; J.nrows = 128; J.mode = 0; break;
        case 11: J.src = p->cw2 + ((size_t)l * 2 + 1) * 256 * 128; J.dst = W + OFF_WC2 + (size_t)128 * 256; J.K = 256; J.Nsrc = 128; J.ldd = 256; J.nrows = 128; J.mode = 0; break;
        default: J.src = p->cw1 + ((size_t)l * 2 + 1) * 4096 * 256; J.dst = W + OFF_WC1 + (size_t)256 * 4096; J.K = 4096; J.Nsrc = 256; J.ldd = 4096; J.nrows = 256; J.mode = 0; break;
    }
    return J;
}
__device__ __forceinline__ void cvt_tile(const CvtJob& J, int tile, const int wv) {
    const int t = TID_OPAQUE(wv), kb = t & 7, n4 = t >> 3;
    const int nbn = (J.nrows + 255) >> 8, n0 = (tile % nbn) * 256 + 4 * n4, k0 = (tile / nbn) * 64 + 8 * kb;
    if (n0 >= J.nrows) return;
    const int sc = colmap(J.mode, n0);
    f32x4 v[8];
#pragma unroll
    for (int jj = 0; jj < 8; ++jj) v[jj] = sc >= 0 ? *(const f32x4*)(J.src + (size_t)(k0 + jj) * J.Nsrc + sc) : (f32x4){0.f, 0.f, 0.f, 0.f};
    if (J.gain) { const f32x4 ga = *(const f32x4*)(J.gain + k0), gb = *(const f32x4*)(J.gain + k0 + 4);
#pragma unroll
        for (int jj = 0; jj < 4; ++jj) { v[jj] *= ga[jj]; v[4 + jj] *= gb[jj]; } }
#pragma unroll
    for (int e = 0; e < 4; ++e) { u32x4 w; w.x = cvt_pk_bf16(v[0][e], v[1][e]); w.y = cvt_pk_bf16(v[2][e], v[3][e]); w.z = cvt_pk_bf16(v[4][e], v[5][e]); w.w = cvt_pk_bf16(v[6][e], v[7][e]);
        *(u32x4*)(J.dst + (size_t)(n0 + e) * J.ldd + k0) = w; }
}
__device__ __forceinline__ void posb_item(const float* cpos, const float* cw1, unsigned char* wsb, int item, float* red, const int wv) {
    const int tid_o = TID_OPAQUE(wv);
    const int lj = item >> 3, hb = item & 7, t = tid_o, hid = hb * 32 + (t & 31), sl = t >> 5;
    const float* pp = cpos + (size_t)lj * 4096 + sl * 256; const float* w = cw1 + (size_t)lj * 4096 * 256 + (size_t)sl * 256 * 256 + hid;
    float s = 0.f;
#pragma unroll 8
    for (int kk = 0; kk < 256; ++kk) s = fmaf(pp[kk], w[(size_t)kk * 256], s);
    __syncthreads();
    red[sl * 32 + (t & 31)] = s;
    __syncthreads();
    if (t < 32) { float a = 0.f;
#pragma unroll
        for (int i = 0; i < 16; ++i) a += red[i * 32 + t];
        ((float*)(wsb + WS_POSB))[lj * 256 + hb * 32 + t] = a; }
}
__device__ __forceinline__ void rms_first_row(const float* x, bf16_t* xb, float* rstd, int row, int lane) {
    const f32x4* xr = (const f32x4*)(x + (size_t)row * DM) + lane;
    f32x4 v[8]; float s = 0.f;
#pragma unroll
    for (int j = 0; j < 8; ++j) { v[j] = xr[64 * j]; s += (v[j][0] * v[j][0] + v[j][1] * v[j][1]) + (v[j][2] * v[j][2] + v[j][3] * v[j][3]); }
    const float rs = rsqrtf(wave_sum(s) * (1.f / DM) + EPS);
    if (lane == 0) rstd[row] = rs;
    u32x2* o = (u32x2*)(xb + (size_t)row * DM) + lane;
#pragma unroll
    for (int j = 0; j < 8; ++j) { u32x2 w; w.x = cvt_pk_bf16(v[j][0] * rs, v[j][1] * rs); w.y = cvt_pk_bf16(v[j][2] * rs, v[j][3] * rs); o[64 * j] = w; }
}
__device__ __forceinline__ void rms_post_row(const float* xf32, const bf16_t* y, const float* ga, bf16_t* xb, float* rstd, float* xout, int row, int lane) {
    const u32x2* yr = (const u32x2*)(y + (size_t)row * DM) + lane; const f32x4* gar = (const f32x4*)ga + lane;
    u32x2* xbr = (u32x2*)(xb + (size_t)row * DM) + lane;
    f32x4 v[8], xv[8]; u32x2 yy[8]; float s = 0.f;
#pragma unroll
    for (int j = 0; j < 8; ++j) yy[j] = yr[64 * j];
    if (xf32) {
#pragma unroll
        for (int j = 0; j < 8; ++j) xv[j] = ((const f32x4*)(xf32 + (size_t)row * DM) + lane)[64 * j];
    } else { const float ir = 1.0f / rstd[row];
#pragma unroll
        for (int j = 0; j < 8; ++j) { const u32x2 xx = xbr[64 * j]; xv[j] = (f32x4){__uint_as_float(xx.x << 16) * ir, __uint_as_float(xx.x & 0xffff0000u) * ir, __uint_as_float(xx.y << 16) * ir, __uint_as_float(xx.y & 0xffff0000u) * ir}; }
    }
#pragma unroll
    for (int j = 0; j < 8; ++j) { v[j] = (f32x4){__uint_as_float(yy[j].x << 16), __uint_as_float(yy[j].x & 0xffff0000u), __uint_as_float(yy[j].y << 16), __uint_as_float(yy[j].y & 0xffff0000u)}; s += (v[j][0] * v[j][0] + v[j][1] * v[j][1]) + (v[j][2] * v[j][2] + v[j][3] * v[j][3]); }
    const float rsy = rsqrtf(wave_sum(s) * (1.f / DM) + EPS);
    float s2 = 0.f;
#pragma unroll
    for (int j = 0; j < 8; ++j) { const f32x4 gg = gar[64 * j];
#pragma unroll
        for (int i = 0; i < 4; ++i) v[j][i] = xv[j][i] + v[j][i] * rsy * gg[i];
        s2 += (v[j][0] * v[j][0] + v[j][1] * v[j][1]) + (v[j][2] * v[j][2] + v[j][3] * v[j][3]); }
    if (xout) { f32x4* xo = (f32x4*)(xout + (size_t)row * DM) + lane;
#pragma unroll
        for (int j = 0; j < 8; ++j) xo[64 * j] = v[j]; }
    else { const float rsx = rsqrtf(wave_sum(s2) * (1.f / DM) + EPS); if (lane == 0) rstd[row] = rsx;
#pragma unroll
        for (int j = 0; j < 8; ++j) { u32x2 n; n.x = cvt_pk_bf16(v[j][0] * rsx, v[j][1] * rsx); n.y = cvt_pk_bf16(v[j][2] * rsx, v[j][3] * rsx); xbr[64 * j] = n; } }
}
__device__ __forceinline__ void cumsum_item(int bh, const float* logf, float* cum, float* part, const int wv) {
    const int tid_o = TID_OPAQUE(wv);
    const int b = bh >> 2, h = bh & 3, t = tid_o;
    float v[8]; float s = 0.f;
#pragma unroll
    for (int i = 0; i < 8; ++i) { s += logf[((size_t)b * SEQ + t * 8 + i) * 4 + h]; v[i] = s; }
    __syncthreads();
    part[t] = s; __syncthreads();
    for (int o = 1; o < 512; o <<= 1) { float a = t >= o ? part[t - o] : 0.f; __syncthreads(); part[t] += a; __syncthreads(); }
    const float base = t ? part[t - 1] : 0.f;
#pragma unroll
    for (int i = 0; i < 8; ++i) cum[(size_t)bh * SEQ + t * 8 + i] = base + v[i];
}
__device__ __forceinline__ void cmp2_item(int item, const bf16_t* h1, const float* w2, bf16_t* kvc, const int wv) {
    const int tid_o = TID_OPAQUE(wv);
    const int row = item * 4 + (tid_o >> 7), n = tid_o & 127, panel = row >> 8, j = panel >> 3;
    const bf16_t* hr = h1 + (size_t)row * 256; const float* w = w2 + (size_t)j * 256 * 128 + n;
    float s = 0.f;
#pragma unroll 8
    for (int k = 0; k < 256; ++k) s = fmaf(bf2f(hr[k]), w[(size_t)k * 128], s);
    kvc[(size_t)row * 128 + n] = f2bf(s);
}
__device__ __forceinline__ void cmp2_panel(int panel, const bf16_t* h1, const bf16_t* w2t, bf16_t* kvc, const int wv) {
    const int lane = lane_id_opaque(), r32 = lane & 31, hi = lane >> 5, row = panel * 256 + 32 * wv + r32, j = panel >> 3;
    const bf16_t* hr = h1 + (size_t)row * 256 + 8 * hi;
    bf16x8 a[16];
#pragma unroll
    for (int s = 0; s < 16; ++s) a[s] = *(const bf16x8*)(hr + 16 * s);
#pragma unroll
    for (int nb = 0; nb < 4; ++nb) {
        f32x16 acc;
#pragma unroll
        for (int i = 0; i < 16; ++i) acc[i] = 0.f;
        const bf16_t* wr = w2t + ((size_t)j * 128 + 32 * nb + r32) * 256 + 8 * hi;
#pragma unroll
        for (int s = 0; s < 16; ++s) { const bf16x8 bw = *(const bf16x8*)(wr + 16 * s); acc = __builtin_amdgcn_mfma_f32_32x32x16_bf16(bw, a[s], acc, 0, 0, 0); }
#pragma unroll
        for (int gq = 0; gq < 4; ++gq) { u32x2 w; w.x = cvt_pk_bf16(acc[4 * gq], acc[4 * gq + 1]); w.y = cvt_pk_bf16(acc[4 * gq + 2], acc[4 * gq + 3]);
            *(u32x2*)(kvc + (size_t)row * 128 + 32 * nb + 8 * gq + 4 * hi) = w; }
        __builtin_amdgcn_sched_barrier(0);
    }
}
struct CmpOrder2 {
    int c;
    __device__ bool next(int i, pg8::Unit& u) const { if (i > 0 || c < 0 || c >= 16) return false; u.pm = c; u.pn = c >> 3; return true; }
};

__device__ __forceinline__ KParams opq_kp() { KParams k = (KParams)__builtin_amdgcn_kernarg_segment_ptr(); asm volatile("" : "+s"(k)); return k; }
#define GAS __attribute__((address_space(1)))
template <class Tp> __device__ __forceinline__ Tp* as_global(Tp* p) { return (Tp*)(GAS Tp*)p; }
#define PRM(f) (as_global(opq_kp()->f))
constexpr int CVT_NJ = 12;
constexpr int cvt_ntile(int j) { return j == 0 ? 23 * 32 : j == 1 ? 24 * 32 : j == 2 ? 8 * 8 : j == 3 ? 8 * 8 : j == 4 ? 8 * 16 : j == 5 ? 8 * 32 : j == 6 ? 44 * 32 : j == 7 ? 8 * 88 : j == 8 ? 64 : j == 9 ? 64 : 4; }
constexpr int cvt_pre(int j) { int s = 0; for (int i = 0; i < j; ++i) s += cvt_ntile(i); return s; }
constexpr int CVT_TILES = cvt_pre(CVT_NJ);
__device__ __forceinline__ void cvt_global_tile(int l, int gt, const int wv) {
    int j = 0;
#pragma unroll
    for (int i = 1; i < CVT_NJ; ++i) j += (gt >= cvt_pre(i)) ? 1 : 0;
    int pre = 0;
#pragma unroll
    for (int i = 1; i < CVT_NJ; ++i) pre = (gt >= cvt_pre(i)) ? cvt_pre(i) : pre;
    const CvtJob J = cvt_job(opq_kp(), l, j);
    cvt_tile(J, gt - pre, wv);
}
__device__ __forceinline__ void flag_wait(unsigned* flag, unsigned* bar, const int wv) {
    __syncthreads();
    if (TID_OPAQUE(wv) == 0) { XB_SPIN(xb_ld(flag) < 16u, bar); __builtin_amdgcn_fence(__ATOMIC_ACQUIRE, "agent"); asm volatile("s_waitcnt vmcnt(0)" ::: "memory"); }
    __syncthreads();
}
#define OPQ_WS() ({ GAS unsigned char* w_ = (GAS unsigned char*)(opq_kp()->ws); asm volatile("" : "+s"(w_)); w_; })
#define WSP(ty, off) ((ty*)(ws + (off)))
__global__ __launch_bounds__(512, 2) void k_mega(Params p_unused) {
    extern __shared__ __attribute__((aligned(16))) unsigned char shm[];
    LAS unsigned char* lds = (LAS unsigned char*)shm;
    const int wv = __builtin_amdgcn_readfirstlane((int)threadIdx.x >> 6), G = (int)gridDim.x, bid = (int)blockIdx.x;
    if (TID_OPAQUE(wv) == 0) *(uint4*)(shm + LDS_BARW) = make_uint4(0u, 0u, 0u, 0u);
    __syncthreads();
    XcdBarrier bar = xcd_barrier_post((unsigned*)(PRM(ws) + WS_CTL), (volatile LAS unsigned*)(lds + LDS_BARW), wv);

    for (int gt = bid; gt < CVT_TILES; gt += G) cvt_global_tile(0, gt, wv);
    for (int it = bid; it < NLAYER * 2 * 8; it += G) posb_item(PRM(cpos), PRM(cw1), PRM(ws), it, (float*)shm, wv);
    { GAS unsigned char* ws = OPQ_WS(); const int t_ = TID_OPAQUE(wv); for (int row = bid * 8 + (t_ >> 6); row < T; row += G * 8) rms_first_row(PRM(x_in), WSP(bf16_t, WS_HB), WSP(float, WS_RSTD), row, t_ & 63); }
    xcd_barrier(bar, wv);

    for (int l = 0; l < NLAYER; ++l) {
        const float lam_init = __int_as_float(__builtin_amdgcn_readfirstlane(__float_as_int(l == 0 ? 0.2f : (l == 1 ? 0.35550906759096934f : (l == 2 ? 0.4707130183435842f : 0.5560582041556406f)))));
        const float oml = __int_as_float(__builtin_amdgcn_readfirstlane(__float_as_int(l == 0 ? 0.8f : (l == 1 ? 0.64449093240903066f : (l == 2 ? 0.5292869816564158f : 0.4439417958443594f)))));
        { GAS unsigned char* ws = OPQ_WS(); const bf16_t* W = WSP(bf16_t, WS_W) + (size_t)l * LW_EL;
          pg8::Gemm g{}; g.A = WSP(bf16_t, WS_HB); g.Bt = W + OFF_W1T; g.M = T; g.N = N1; g.K = DM; g.lda = DM; g.ldb = DM;
          pg8::Epi1 e{}; e.qkv = WSP(bf16_t, WS_QKV); e.logf = WSP(float, WS_LOGF); e.nsag = WSP(float, WS_NSAG); e.gates = WSP(bf16_t, WS_GATES); e.fbias = PRM(fbias) + l * 4; e.rstd = WSP(float, WS_RSTD); e.kbound = (unsigned*)(ws + WS_CTL + CTL_KB) + l * 256;
          int bq = bid; asm volatile("" : "+s"(bq)); pg8::StaticOrder S; S.init(g.M, g.N, G, bq);
          pg8::gemm_phase<pg8::Epi1, pg8::StaticOrder>(lds, g, S, e, wv); }
        if (l + 1 < NLAYER && bid >= (64 * 47) % G) { GAS unsigned char* ws = OPQ_WS(); unsigned* ctr = (unsigned*)(ws + WS_CTL + 16384) + 64 * ((l * 4 + 3) * 8); LAS int* slot = (LAS int*)(lds + att::L_SLOT);
          const int it = att::queue_next(ctr, slot, wv);
          if (it * 8 < CVT_TILES) {
#pragma unroll 1
              for (int u = 0; u < 8; ++u) { const int gt = it * 8 + u; if (gt < CVT_TILES) cvt_global_tile(l + 1, gt, wv); } }
          __syncthreads(); }
        xcd_barrier(bar, wv);
        { GAS unsigned char* ws = OPQ_WS(); const bf16_t* W = WSP(bf16_t, WS_W) + (size_t)l * LW_EL;
          int bq = bid; asm volatile("" : "+s"(bq));
          pg8::Gemm g{}; g.A = WSP(bf16_t, WS_QKV) + (size_t)SL_NKC * 4 * SEQ * HD; g.Bt = W + OFF_WC1; g.M = 4096; g.N = 512; g.K = 4096; g.lda = 2048; g.ldb = 4096;
          pg8::EpiC1 e{}; e.h1 = WSP(bf16_t, WS_H1); e.posb = WSP(float, WS_POSB) + l * 512;
          CmpOrder2 S; S.c = bq;
          pg8::gemm_phase<pg8::EpiC1, CmpOrder2>(lds, g, S, e, wv);
          if (bq < 16) { asm volatile("s_waitcnt vmcnt(0)" ::: "memory"); __syncthreads();
              cmp2_panel(bq, WSP(bf16_t, WS_H1), W + OFF_WC2, WSP(bf16_t, WS_KVC), wv); }
          else if (bq < 32) cumsum_item(bq - 16, WSP(float, WS_LOGF), WSP(float, WS_CUM), (float*)shm, wv);
          if (bq < 32) {
              asm volatile("s_waitcnt vmcnt(0)" ::: "memory"); __syncthreads();
              if (TID_OPAQUE(wv) == 0) { __builtin_amdgcn_fence(__ATOMIC_RELEASE, "agent"); xb_add((unsigned*)(ws + WS_CTL + 49152) + 64 * (l * 2 + (bq >> 4)), 1u); } } }
        { GAS unsigned char* ws = OPQ_WS(); LAS int* slot = (LAS int*)(lds + att::L_SLOT); const int myx = (int)(xb_xcc_id() & 7u);
          for (int dx = 0; dx < 8; ++dx) { const int x = (myx + dx) & 7; unsigned* ctr = (unsigned*)(ws + WS_CTL + 16384) + 64 * ((l * 4 + 1) * 8 + x);
            for (;;) { const int it = att::queue_next(ctr, slot, wv); if (it >= 32) break;
              att::diff_item((x >> 1) * 4 + 2 + (x & 1), 31 - it, lds, WSP(bf16_t, WS_QKV), (const unsigned*)(ws + WS_CTL + CTL_KB) + l * 256, PRM(dlam) + l * 256, PRM(subln) + l * 128, lam_init, oml, WSP(bf16_t, WS_ATT), wv); } }
          __syncthreads(); }
        { GAS unsigned char* ws = OPQ_WS(); LAS int* slot = (LAS int*)(lds + att::L_SLOT); const int myx = (int)(xb_xcc_id() & 7u);
          flag_wait((unsigned*)(ws + WS_CTL + 49152) + 64 * (l * 2 + 1), (unsigned*)(ws + WS_CTL), wv);
          for (int dx = 0; dx < 8; ++dx) { const int x = (myx + dx) & 7; unsigned* ctr = (unsigned*)(ws + WS_CTL + 16384) + 64 * ((l * 4 + 0) * 8 + x);
            for (;;) { const int it = att::queue_next(ctr, slot, wv); if (it >= 32) break;
              att::fox_item(2 * x + (it & 1), 15 - (it >> 1), lds, WSP(bf16_t, WS_QKV), WSP(float, WS_CUM), WSP(bf16_t, WS_ATT), wv); } }
          __syncthreads(); }
        { GAS unsigned char* ws = OPQ_WS(); LAS int* slot = (LAS int*)(lds + att::L_SLOT); const int myx = (int)(xb_xcc_id() & 7u);
          flag_wait((unsigned*)(ws + WS_CTL + 49152) + 64 * (l * 2 + 0), (unsigned*)(ws + WS_CTL), wv);
          for (int dx = 0; dx < 8; ++dx) { const int x = (myx + dx) & 7; unsigned* ctr = (unsigned*)(ws + WS_CTL + 16384) + 64 * ((l * 4 + 2) * 8 + x);
            for (;;) { const int it = att::queue_next(ctr, slot, wv); if (it >= 64) break;
              att::nsa_item(x, 63 - it, lds, WSP(bf16_t, WS_QKV), WSP(bf16_t, WS_KVC), WSP(float, WS_NSAG), (const unsigned*)(ws + WS_CTL + CTL_KB) + l * 256, WSP(bf16_t, WS_ATT), wv); } }
          __syncthreads(); }
        { GAS unsigned char* ws = OPQ_WS(); LAS int* slot = (LAS int*)(lds + att::L_SLOT); const int myx = (int)(xb_xcc_id() & 7u);
          for (int dx = 0; dx < 8; ++dx) { const int x = (myx + dx) & 7; unsigned* ctr = (unsigned*)(ws + WS_CTL + 53248) + 64 * (l * 8 + x);
            for (;;) { const int it = att::queue_next(ctr, slot, wv); if (it >= 32) break;
              att::diff_item((x >> 1) * 4 + (x & 1), 31 - it, lds, WSP(bf16_t, WS_QKV), (const unsigned*)(ws + WS_CTL + CTL_KB) + l * 256, PRM(dlam) + l * 256, PRM(subln) + l * 128, lam_init, oml, WSP(bf16_t, WS_ATT), wv); } }
          __syncthreads(); }
        if (l + 1 < NLAYER) { GAS unsigned char* ws = OPQ_WS(); unsigned* ctr = (unsigned*)(ws + WS_CTL + 16384) + 64 * ((l * 4 + 3) * 8); LAS int* slot = (LAS int*)(lds + att::L_SLOT);
          for (;;) { const int it = att::queue_next(ctr, slot, wv); if (it * 8 >= CVT_TILES) break;
#pragma unroll 1
              for (int u = 0; u < 8; ++u) { const int gt = it * 8 + u; if (gt < CVT_TILES) cvt_global_tile(l + 1, gt, wv); } }
          __syncthreads(); }
        xcd_barrier(bar, wv);
        { GAS unsigned char* ws = OPQ_WS(); const bf16_t* W = WSP(bf16_t, WS_W) + (size_t)l * LW_EL;
          pg8::Gemm g{}; g.A = WSP(bf16_t, WS_ATT); g.Bt = W + OFF_WBT; g.M = T; g.N = DM; g.K = DM; g.lda = DM; g.ldb = DM;
          pg8::Epi2 e{}; e.gates = WSP(bf16_t, WS_GATES); e.out = WSP(bf16_t, WS_MRG);
          int bq = bid; asm volatile("" : "+s"(bq)); pg8::StaticOrder S; S.init(g.M, g.N, G, bq);
          pg8::gemm_phase<pg8::Epi2, pg8::StaticOrder>(lds, g, S, e, wv); }
        xcd_barrier(bar, wv);
        { GAS unsigned char* ws = OPQ_WS(); const bf16_t* W = WSP(bf16_t, WS_W) + (size_t)l * LW_EL;
          pg8::Gemm g{}; g.A = WSP(bf16_t, WS_MRG); g.Bt = W + OFF_WOT; g.M = T; g.N = DM; g.K = DM; g.lda = DM; g.ldb = DM;
          pg8::EpiBf16P e{}; e.C = WSP(bf16_t, WS_Y); e.ldc = DM;
          int bq = bid; asm volatile("" : "+s"(bq)); pg8::StaticOrder S; S.init(g.M, g.N, G, bq);
          pg8::gemm_phase<pg8::EpiBf16P, pg8::StaticOrder>(lds, g, S, e, wv); }
        xcd_barrier(bar, wv);
        { GAS unsigned char* ws = OPQ_WS(); const float* gl = PRM(gains) + (size_t)l * 4 * DM; const int t_ = TID_OPAQUE(wv);
          for (int row = bid * 8 + (t_ >> 6); row < T; row += G * 8) rms_post_row(l == 0 ? PRM(x_in) : (const float*)nullptr, WSP(bf16_t, WS_Y), gl + DM, WSP(bf16_t, WS_HB), WSP(float, WS_RSTD), (float*)nullptr, row, t_ & 63); }
        xcd_barrier(bar, wv);
        { GAS unsigned char* ws = OPQ_WS(); const bf16_t* W = WSP(bf16_t, WS_W) + (size_t)l * LW_EL;
          pg8::Gemm g{}; g.A = WSP(bf16_t, WS_HB); g.Bt = W + OFF_WUP; g.M = T; g.N = 2 * DFF; g.K = DM; g.lda = DM; g.ldb = DM;
          pg8::EpiSwiGLU e{}; e.hid = WSP(bf16_t, WS_HID); e.rstd = WSP(float, WS_RSTD);
          int bq = bid; asm volatile("" : "+s"(bq)); pg8::StaticOrder S; S.init(g.M, g.N, G, bq);
          pg8::gemm_phase<pg8::EpiSwiGLU, pg8::StaticOrder>(lds, g, S, e, wv); }
        xcd_barrier(bar, wv);
        { GAS unsigned char* ws = OPQ_WS(); const bf16_t* W = WSP(bf16_t, WS_W) + (size_t)l * LW_EL;
          pg8::Gemm g{}; g.A = WSP(bf16_t, WS_HID); g.Bt = W + OFF_WDN; g.M = T; g.N = DM; g.K = DFF; g.lda = DFF; g.ldb = DFF;
          pg8::EpiBf16P e{}; e.C = WSP(bf16_t, WS_Y); e.ldc = DM;
          int bq = bid; asm volatile("" : "+s"(bq)); pg8::StaticOrder S; S.init(g.M, g.N, G, bq);
          pg8::gemm_phase<pg8::EpiBf16P, pg8::StaticOrder>(lds, g, S, e, wv); }
        xcd_barrier(bar, wv);
        { GAS unsigned char* ws = OPQ_WS(); const float* gl = PRM(gains) + (size_t)l * 4 * DM; const int t_ = TID_OPAQUE(wv);
          for (int row = bid * 8 + (t_ >> 6); row < T; row += G * 8) rms_post_row((const float*)nullptr, WSP(bf16_t, WS_Y), gl + 3 * DM, WSP(bf16_t, WS_HB), WSP(float, WS_RSTD), l + 1 < NLAYER ? (float*)nullptr : PRM(xo), row, t_ & 63); }
        if (l + 1 < NLAYER) xcd_barrier(bar, wv);
    }
}

extern "C" void kernel_launch(void* const* d_in, const int* in_sizes, int n_in, void* d_out, int out_size, void* d_ws, size_t ws_size, hipStream_t stream) {
    static int grid = 0;
    if (grid == 0) {
        if (n_in != 16 || ws_size < WS_END) { fprintf(stderr, "kernel_launch: bad arguments n_in %d ws %zu need %zu\n", n_in, ws_size, (size_t)WS_END); grid = -1; return; }
        int dev = 0, cus = 0, per_cu = 0;
        if (hipGetDevice(&dev) != hipSuccess || hipDeviceGetAttribute(&cus, hipDeviceAttributeMultiprocessorCount, dev) != hipSuccess) { grid = -1; return; }
        if (hipFuncSetAttribute((const void*)k_mega, hipFuncAttributeMaxDynamicSharedMemorySize, LDS_TOTAL) != hipSuccess) { fprintf(stderr, "kernel_launch: hipFuncSetAttribute failed\n"); grid = -1; return; }
        if (hipOccupancyMaxActiveBlocksPerMultiprocessor(&per_cu, (const void*)k_mega, 512, LDS_TOTAL) != hipSuccess || per_cu < 1) { fprintf(stderr, "kernel_launch: occupancy query says %d\n", per_cu); }
        (void)hipGetLastError();
        grid = cus > 0 ? cus : 256;
    }
    if (grid < 0) return;
    if (hipMemsetAsync((char*)d_ws + WS_CTL, 0, CTL_BYTES, stream) != hipSuccess) return;
    Params p{};
    p.x_in = (const float*)d_in[0]; p.w_in = (const float*)d_in[1]; p.fbias = (const float*)d_in[2]; p.dlam = (const float*)d_in[3]; p.subln = (const float*)d_in[4];
    p.cpos = (const float*)d_in[5]; p.cw1 = (const float*)d_in[6]; p.cw2 = (const float*)d_in[7]; p.wbf = (const float*)d_in[8]; p.wbd = (const float*)d_in[9];
    p.wbn = (const float*)d_in[10]; p.wgate = (const float*)d_in[11]; p.wout = (const float*)d_in[12]; p.gains = (const float*)d_in[13]; p.wup = (const float*)d_in[14];
    p.wdn = (const float*)d_in[15]; p.xo = (float*)d_out; p.ws = (unsigned char*)d_ws;
    hipLaunchKernelGGL(k_mega, dim3(grid), dim3(512), LDS_TOTAL, stream, p);
}
```

```cpp
#include <hip/hip_runtime.h>
#include <cstdio>
#include <cstdint>
#include <cmath>

#define LAS __attribute__((address_space(3)))
typedef unsigned short bf16_t;
typedef short bf16x8 __attribute__((ext_vector_type(8)));
typedef short s16x4 __attribute__((ext_vector_type(4)));
typedef float f32x4 __attribute__((ext_vector_type(4)));
typedef float f32x16 __attribute__((ext_vector_type(16)));
typedef unsigned u32x4 __attribute__((ext_vector_type(4)));
typedef unsigned u32x2 __attribute__((ext_vector_type(2)));

constexpr int T = 16384, DM = 2048, NBATCH = 4, SEQ = 4096, NLAYER = 4;
constexpr int IN_COLS = 5660, DFF = 5632, HD = 128;
constexpr int N1 = 12032;
constexpr int NSLOT = 44;
constexpr float EPS = 1e-6f;

constexpr int SL_FQ = 0, SL_FK = 4, SL_FV = 8, SL_DQ = 12, SL_DK = 16, SL_DV = 20, SL_NQ = 24, SL_NKC = 32, SL_NVC = 34, SL_NKS = 36, SL_NVS = 38, SL_NKW = 40, SL_NVW = 42;

constexpr size_t al256(size_t x) { return (x + 255) & ~(size_t)255; }
constexpr size_t WS_CTL   = 0;
constexpr size_t CTL_BYTES = 131072;
constexpr size_t CTL_KB = 65536;
constexpr size_t W1T_EL  = (size_t)N1 * DM;
constexpr size_t WBT_EL  = (size_t)DM * DM;
constexpr size_t WOT_EL  = (size_t)DM * DM;
constexpr size_t WUP_EL  = (size_t)2 * DFF * DM;
constexpr size_t WDN_EL  = (size_t)DM * DFF;
constexpr size_t WC1_EL  = (size_t)2 * 256 * 4096;
constexpr size_t WC2_EL  = (size_t)2 * 128 * 256;
constexpr size_t LW_EL   = W1T_EL + WBT_EL + WOT_EL + WUP_EL + WDN_EL + WC1_EL + WC2_EL;
constexpr size_t OFF_W1T = 0, OFF_WBT = OFF_W1T + W1T_EL, OFF_WOT = OFF_WBT + WBT_EL, OFF_WUP = OFF_WOT + WOT_EL, OFF_WDN = OFF_WUP + WUP_EL, OFF_WC1 = OFF_WDN + WDN_EL, OFF_WC2 = OFF_WC1 + WC1_EL;
constexpr size_t WS_W     = WS_CTL + CTL_BYTES;
constexpr size_t WS_POSB  = al256(WS_W + (size_t)NLAYER * LW_EL * 2);
constexpr size_t WS_HB    = al256(WS_POSB + (size_t)NLAYER * 2 * 256 * 4);
constexpr size_t WS_QKV   = al256(WS_HB + (size_t)T * DM * 2);
constexpr size_t QKV_BYTES = (size_t)NSLOT * NBATCH * SEQ * HD * 2;
constexpr size_t WS_GATES = al256(WS_QKV + QKV_BYTES + 65536);
constexpr size_t WS_HID   = WS_QKV;
constexpr size_t WS_ATT   = al256(WS_GATES + (size_t)3 * T * DM * 2);
constexpr size_t WS_MRG   = al256(WS_ATT + (size_t)T * DM * 2);
constexpr size_t WS_Y     = al256(WS_MRG + (size_t)T * DM * 2);
constexpr size_t WS_LOGF  = al256(WS_Y + (size_t)T * DM * 4);
constexpr size_t WS_NSAG  = al256(WS_LOGF + (size_t)T * 4 * 4);
constexpr size_t WS_CUM   = al256(WS_NSAG + (size_t)T * 24 * 4);
constexpr size_t WS_H1    = al256(WS_CUM + (size_t)16 * SEQ * 4);
constexpr size_t WS_KVC   = al256(WS_H1 + (size_t)16 * 256 * 256 * 2);
constexpr size_t WS_SELM  = al256(WS_KVC + (size_t)16 * 256 * 128 * 2);
constexpr size_t WS_RSTD  = al256(WS_SELM + (size_t)NBATCH * 2 * SEQ * 8);
constexpr size_t WS_XR    = al256(WS_RSTD + (size_t)T * 4);
constexpr size_t WS_END   = al256(WS_XR + (size_t)T * DM * 2);
static_assert((size_t)T * DFF * 2 <= (WS_ATT - WS_QKV), "HID overlay must fit in QKV + GATES");

__device__ __forceinline__ float bf2f(bf16_t b) { return __uint_as_float(((unsigned)b) << 16); }
__device__ __forceinline__ bf16_t f2bf(float f) { unsigned u = __float_as_uint(f); u += 0x7FFFu + ((u >> 16) & 1u); return (bf16_t)(u >> 16); }
typedef __bf16 bf16v2_t __attribute__((ext_vector_type(2)));
typedef float f32v2_t __attribute__((ext_vector_type(2)));
__device__ __forceinline__ unsigned cvt_pk_bf16(float lo, float hi) { const f32v2_t v = {lo, hi}; const bf16v2_t b = __builtin_convertvector(v, bf16v2_t); return __builtin_bit_cast(unsigned, b); }
__device__ __forceinline__ float sigmoidf_(float v) { return __builtin_amdgcn_rcpf(1.0f + __expf(-v)); }
#define SWZ_XOR(v, k) __int_as_float(__builtin_amdgcn_ds_swizzle(__float_as_int(v), ((k) << 10) | 0x1f))
__device__ __forceinline__ float wave_sum(float v) {
    v += SWZ_XOR(v, 1); v += SWZ_XOR(v, 2); v += SWZ_XOR(v, 4); v += SWZ_XOR(v, 8); v += SWZ_XOR(v, 16);
    auto rr = __builtin_amdgcn_permlane32_swap(__float_as_uint(v), __float_as_uint(v), false, false); return __uint_as_float(rr[0]) + __uint_as_float(rr[1]);
}
__device__ __forceinline__ float wave_max(float v) {
    v = fmaxf(v, SWZ_XOR(v, 1)); v = fmaxf(v, SWZ_XOR(v, 2)); v = fmaxf(v, SWZ_XOR(v, 4)); v = fmaxf(v, SWZ_XOR(v, 8)); v = fmaxf(v, SWZ_XOR(v, 16));
    auto rr = __builtin_amdgcn_permlane32_swap(__float_as_uint(v), __float_as_uint(v), false, false); return fmaxf(__uint_as_float(rr[0]), __uint_as_float(rr[1]));
}

__device__ __forceinline__ int lane_id_opaque() { int l = (int)__builtin_amdgcn_mbcnt_hi(~0u, __builtin_amdgcn_mbcnt_lo(~0u, 0u)); asm volatile("" : "+v"(l)); return l; }
#define TID_OPAQUE(wv) ((wv) * 64 + lane_id_opaque())

namespace pg8 {
constexpr int BM = 256, BK = 64, HALF = 128, HTB = HALF * BK * 2, STAGE_BYTES = 8 * HTB, NXCD = 8, WGM = 4;
__host__ __device__ __forceinline__ int lds_byte(int r, int c) { const int st = (r >> 4) * 2 + (c >> 5), rr = r & 15, cc = c & 31, ob = rr * 64 + cc * 2; return st * 1024 + (ob ^ (((ob >> 9) & 1) << 5)); }
__host__ __device__ __forceinline__ void stage_rc(int b, int& R, int& C) { const int st = b / 1024, sb = b % 1024, swz = sb ^ (((sb >> 9) & 1) << 5); R = (st >> 1) * 16 + swz / 64; C = (st & 1) * 32 + (swz % 64) / 2; }
__host__ __device__ __forceinline__ int perm32(int rho) { const int n = rho >> 4, i = rho & 15; return 8 * (i >> 2) + 4 * n + (i & 3); }

struct Unit { int pm, pn, ko; };
struct Gemm { const bf16_t* A; const bf16_t* Bt; int M, N, K, lda, ldb, pad; };

struct StaticOrder {
    int nM, nN, nwg, G, c;
    __host__ __device__ void init(int M, int N, int G_, int c_) { nM = M / BM; nN = N / BM; nwg = nM * nN; G = G_; c = c_; }
    __host__ __device__ bool next(int i, Unit& u) const {
        const long L = (long)i * G + c; if (L >= nwg) return false;
        int wgid = (int)L; { const int q = nwg / NXCD, r = nwg % NXCD, xcd = wgid % NXCD, off = wgid / NXCD; wgid = (xcd < r ? xcd * (q + 1) : r * (q + 1) + (xcd - r) * q) + off; }
        const int nig = WGM * nN, gid = wgid / nig, fm = gid * WGM, gsz = (nM - fm) < WGM ? (nM - fm) : WGM;
        u.pm = fm + ((wgid % nig) % gsz); u.pn = (wgid % nig) / gsz; u.ko = 0; return true;
    }
};
struct CmpOrder {
    int G, c;
    __host__ __device__ void init(int, int, int G_, int c_) { G = G_; c = c_; }
    __host__ __device__ bool next(int i, Unit& u) const { const int Lx = i * G + c; if (Lx >= 16) return false; u.pm = Lx; u.pn = Lx >> 3; u.ko = 0; return true; }
};

typedef f32x4 Acc[2][2][4][2];

template <class Epi, class Sched>
__device__ __forceinline__ void gemm_phase(LAS unsigned char* lds, const Gemm g, const Sched& S, const Epi& E, const int wv) {
    int wid_o = wv; asm volatile("" : "+s"(wid_o));
    const int wid = wid_o, tid = wid * 64 + lane_id_opaque(), lane = tid & 63, wr = wid >> 2, wc = wid & 3, fr = lane & 15, fq = lane >> 4;
    const int K = g.K, nt = K / BK;
    unsigned voffA[2], voffB[2];
#pragma unroll
    for (int i = 0; i < 2; ++i) { int R, C; stage_rc(tid * 16 + i * 8192, R, C); const int Rb = Epi::PERM ? ((R & ~31) + perm32(R & 31)) : R;
        voffA[i] = (unsigned)(R * g.lda + C) * 2u; voffB[i] = (unsigned)(Rb * g.ldb + C) * 2u; }
    const size_t kstep = (size_t)(BK * 2);
    const size_t hstepA = (size_t)HALF * g.lda * 2, hstepB = (size_t)HALF * g.ldb * 2;
    const size_t tstepA = 2 * hstepA, tstepB = 2 * hstepB;
    const unsigned ldsw = (unsigned)wid * 1024u;
    const int aoff = lds_byte(wr * 64 + fr, fq * 8), boff = lds_byte(wc * 32 + fr, fq * 8);
#define PG8_SA(b, h) (((b) * 2 + (h)) * HTB)
#define PG8_SB(b, h) ((4 + (b) * 2 + (h)) * HTB)
#define PG8_STAGE(bufoff, gbase, voff) do { _Pragma("unroll") for (int _i = 0; _i < 2; ++_i) \
        __builtin_amdgcn_global_load_lds((const unsigned*)((const char*)(gbase) + (voff)[_i]), (LAS unsigned*)(lds + (bufoff) + ldsw + _i * 8192), 16, 0, 0); } while (0)
#define PG8_LDA(dst, b, h) do { _Pragma("unroll") for (int m = 0; m < 4; ++m) _Pragma("unroll") for (int k = 0; k < 2; ++k) dst[m][k] = *(const LAS bf16x8*)(lds + PG8_SA(b, h) + aoff + m * 2048 + k * 1024); } while (0)
#define PG8_LDB(dst, b, h) do { _Pragma("unroll") for (int n = 0; n < 2; ++n) _Pragma("unroll") for (int k = 0; k < 2; ++k) dst[n][k] = *(const LAS bf16x8*)(lds + PG8_SB(b, h) + boff + n * 2048 + k * 1024); } while (0)
#define PG8_MMA(ai, bj, At, Bt) do { __builtin_amdgcn_s_setprio(1); _Pragma("unroll") for (int m = 0; m < 4; ++m) _Pragma("unroll") for (int n = 0; n < 2; ++n) _Pragma("unroll") for (int k = 0; k < 2; ++k) \
        acc[ai][bj][m][n] = __builtin_amdgcn_mfma_f32_16x16x32_bf16(Bt[n][k], At[m][k], acc[ai][bj][m][n], 0, 0, 0); __builtin_amdgcn_s_setprio(0); } while (0)
#define PG8_WAIT_V(n) asm volatile("s_waitcnt vmcnt(" #n ")" ::: "memory")
#define PG8_WAIT_L(n) asm volatile("s_waitcnt lgkmcnt(" #n ")" ::: "memory")
#define PG8_BAR __builtin_amdgcn_s_barrier()
#define PG8_SCHED __builtin_amdgcn_sched_barrier(0)
    Unit cur, nxt; int ui = 0;
    if (!S.next(0, cur)) return;
    f32x4 acc[2][2][4][2];
#pragma unroll
    for (int a = 0; a < 2; ++a)
#pragma unroll
        for (int b = 0; b < 2; ++b)
#pragma unroll
            for (int m = 0; m < 4; ++m)
#pragma unroll
                for (int n = 0; n < 2; ++n) acc[a][b][m][n] = (f32x4){0.f, 0.f, 0.f, 0.f};
    bf16x8 At[4][2], B0[2][2], B1[2][2];
    const char* cA = (const char*)g.A + (size_t)cur.pm * tstepA + (size_t)cur.ko * 2; const char* cB = (const char*)g.Bt + (size_t)cur.pn * tstepB + (size_t)cur.ko * 2;
    PG8_STAGE(PG8_SB(0, 0), cB, voffB); PG8_STAGE(PG8_SB(0, 1), cB + hstepB, voffB); PG8_STAGE(PG8_SA(0, 0), cA, voffA); PG8_STAGE(PG8_SA(0, 1), cA + hstepA, voffA);
    if (wr == 1) PG8_BAR;
    PG8_WAIT_V(2); PG8_BAR;
    PG8_STAGE(PG8_SB(1, 0), cB + kstep, voffB); PG8_STAGE(PG8_SA(1, 0), cA + kstep, voffA); PG8_STAGE(PG8_SB(1, 1), cB + hstepB + kstep, voffB);
    PG8_WAIT_V(6); PG8_BAR;
    for (;;) {
        const bool has_next = S.next(ui + 1, nxt);
        const char* nA = has_next ? (const char*)g.A + (size_t)nxt.pm * tstepA + (size_t)nxt.ko * 2 : cA; const char* nB = has_next ? (const char*)g.Bt + (size_t)nxt.pn * tstepB + (size_t)nxt.ko * 2 : cB;
        for (int t = 0; t < nt; t += 2) {
            if constexpr (Epi::HOOK) { if (t == Epi::H1 || t == Epi::H2) E.mid(acc, cur, t, wr, wc, fr, fq); }
            const bool last = (t == nt - 2);
            const char* a1 = cA + (size_t)(t + 1) * kstep;
            const char* a2 = last ? nA : cA + (size_t)(t + 2) * kstep; const char* b2 = last ? nB : cB + (size_t)(t + 2) * kstep;
            const char* a3 = a2 + kstep; const char* b3 = b2 + kstep;
            PG8_LDB(B0, 0, 0); PG8_LDB(B1, 0, 1); PG8_SCHED; PG8_LDA(At, 0, 0); PG8_STAGE(PG8_SA(1, 1), a1 + hstepA, voffA);
            PG8_WAIT_V(8); PG8_WAIT_L(0); PG8_BAR; PG8_MMA(0, 0, At, B0); PG8_MMA(0, 1, At, B1); PG8_BAR; PG8_SCHED;
            PG8_LDA(At, 0, 1); PG8_STAGE(PG8_SB(0, 0), b2, voffB); PG8_STAGE(PG8_SB(0, 1), b2 + hstepB, voffB); PG8_STAGE(PG8_SA(0, 0), a2, voffA);
            PG8_WAIT_V(8); PG8_WAIT_L(0); PG8_BAR; PG8_MMA(1, 0, At, B0); PG8_MMA(1, 1, At, B1); PG8_BAR; PG8_SCHED;
            PG8_LDB(B0, 1, 0); PG8_LDB(B1, 1, 1); PG8_SCHED; PG8_LDA(At, 1, 0); PG8_STAGE(PG8_SA(0, 1), a2 + hstepA, voffA);
            PG8_WAIT_V(8); PG8_WAIT_L(0); PG8_BAR; PG8_MMA(0, 0, At, B0); PG8_MMA(0, 1, At, B1); PG8_BAR; PG8_SCHED;
            PG8_LDA(At, 1, 1); PG8_STAGE(PG8_SB(1, 0), b3, voffB); PG8_STAGE(PG8_SB(1, 1), b3 + hstepB, voffB); PG8_STAGE(PG8_SA(1, 0), a3, voffA);
            PG8_WAIT_V(8); PG8_WAIT_L(0); PG8_BAR; PG8_MMA(1, 0, At, B0); PG8_MMA(1, 1, At, B1); PG8_BAR; PG8_SCHED;
        }
        if (wr == 0) PG8_BAR;
        E(acc, cur, wr, wc, fr, fq);
        if (!has_next) break;
#pragma unroll
        for (int a = 0; a < 2; ++a)
#pragma unroll
            for (int b = 0; b < 2; ++b)
#pragma unroll
                for (int m = 0; m < 4; ++m)
#pragma unroll
                    for (int n = 0; n < 2; ++n) acc[a][b][m][n] = (f32x4){0.f, 0.f, 0.f, 0.f};
        cur = nxt; cA = nA; cB = nB; ++ui;
        if (wr == 1) PG8_BAR;
    }
    PG8_WAIT_V(0);
    PG8_BAR;
#undef PG8_SA
#undef PG8_SB
#undef PG8_STAGE
#undef PG8_LDA
#undef PG8_LDB
#undef PG8_MMA
#undef PG8_WAIT_V
#undef PG8_WAIT_L
#undef PG8_BAR
#undef PG8_SCHED
}

__device__ __forceinline__ u32x4 pack8(const f32x4 v0, const f32x4 v1) { u32x4 w; w.x = cvt_pk_bf16(v0[0], v0[1]); w.y = cvt_pk_bf16(v0[2], v0[3]); w.z = cvt_pk_bf16(v1[0], v1[1]); w.w = cvt_pk_bf16(v1[2], v1[3]); return w; }

struct Epi1 {
    static constexpr bool PERM = true, HOOK = false; static constexpr int H1 = -1, H2 = -1;
    bf16_t* qkv; float* logf; float* nsag; bf16_t* gates; const float* fbias; const float* rstd; unsigned* kbound;
    __device__ __forceinline__ void operator()(const Acc& acc, const Unit& u, int wr, int wc, int fr, int fq) const {
        const int row0 = u.pm * BM + wr * 64 + fr;
        if (u.pn < 22) {
#pragma unroll
            for (int ai = 0; ai < 2; ++ai)
#pragma unroll
                for (int m = 0; m < 4; ++m) { const int r = row0 + ai * HALF + m * 16, b = r >> 12, s = r & 4095;
#pragma unroll
                    for (int bj = 0; bj < 2; ++bj) { const int slot = 2 * u.pn + bj;
                        bf16_t* dst = qkv + (((size_t)(slot * 4 + b) * SEQ + s) * HD + wc * 32 + 8 * fq);
                        *(u32x4*)dst = pack8(acc[ai][bj][m][0], acc[ai][bj][m][1]); } }
            if (u.pn == 2 || u.pn == 3 || u.pn == 8 || u.pn == 9 || u.pn == 18 || u.pn == 20) {
                float pmx[2] = {0.f, 0.f};
#pragma unroll
                for (int ai = 0; ai < 2; ++ai)
#pragma unroll
                    for (int m = 0; m < 4; ++m) {
#pragma unroll
                        for (int bj = 0; bj < 2; ++bj) { const f32x4 v0 = acc[ai][bj][m][0], v1 = acc[ai][bj][m][1];
                            const float ss = ((v0[0] * v0[0] + v0[1] * v0[1]) + (v0[2] * v0[2] + v0[3] * v0[3])) + ((v1[0] * v1[0] + v1[1] * v1[1]) + (v1[2] * v1[2] + v1[3] * v1[3]));
                            pmx[bj] = fmaxf(pmx[bj], ss); } }
#pragma unroll
                for (int bj = 0; bj < 2; ++bj) { float v = pmx[bj]; v = fmaxf(v, SWZ_XOR(v, 1)); v = fmaxf(v, SWZ_XOR(v, 2)); v = fmaxf(v, SWZ_XOR(v, 4)); v = fmaxf(v, SWZ_XOR(v, 8));
                    const int kr = u.pn < 4 ? 32 + (2 * u.pn + bj) - 4 : (u.pn < 10 ? (2 * u.pn + bj) - 16 : (u.pn == 18 ? 16 + bj : 18 + bj));
                    if (fr == 0) atomicMax(kbound + ((kr * 4 + (row0 >> 12)) * 16 + 4 * wc + fq), __float_as_uint(v)); }
            }
        } else if (u.pn == 22) {
            if (wc == 0) {
#pragma unroll
                for (int ai = 0; ai < 2; ++ai)
#pragma unroll
                    for (int m = 0; m < 4; ++m) { const int r = row0 + ai * HALF + m * 16;
#pragma unroll
                        for (int n = 0; n < 2; ++n)
#pragma unroll
                            for (int i = 0; i < 4; ++i) { const int c = 8 * fq + 4 * n + i; const float v = acc[ai][0][m][n][i];
                                if (c < 4) { const float z = v + fbias[c]; logf[(size_t)r * 4 + c] = fminf(z, 0.f) - log1pf(expf(-fabsf(z))); }
                                else if (c < 28) nsag[(size_t)r * 24 + (c - 4)] = 1.0f / (1.0f + expf(-v)); } }
            }
        } else {
            const int pg = u.pn - 23, bidx = pg >> 3, colt = (pg & 7) * 256;
            unsigned char* gq = (unsigned char*)gates;
#pragma unroll
            for (int ai = 0; ai < 2; ++ai)
#pragma unroll
                for (int m = 0; m < 4; ++m) { const int r = row0 + ai * HALF + m * 16;
#pragma unroll
                    for (int bj = 0; bj < 2; ++bj) { const f32x4 v0 = acc[ai][bj][m][0], v1 = acc[ai][bj][m][1]; u32x2 w = {0u, 0u};
#pragma unroll
                        for (int i = 0; i < 4; ++i) {
                            w.x = __builtin_amdgcn_cvt_pk_u8_f32(fmaxf(sigmoidf_(v0[i]) * 255.f, 1.f), i, w.x); w.y = __builtin_amdgcn_cvt_pk_u8_f32(fmaxf(sigmoidf_(v1[i]) * 255.f, 1.f), i, w.y); }
                        *(u32x2*)(gq + (((size_t)bidx * T + r) * DM + colt + bj * HALF + wc * 32 + 8 * fq)) = w; } }
        }
    }
};

struct Epi2 {
    static constexpr bool PERM = true, HOOK = true; static constexpr int H1 = 8, H2 = 16;
    const bf16_t* gates; bf16_t* out;
    __device__ __forceinline__ void mid(Acc& acc, const Unit& u, int t, int wr, int wc, int fr, int fq) const {
        int row0 = u.pm * BM + wr * 64 + fr; asm volatile("" : "+v"(row0));
        const unsigned char* ga = (const unsigned char*)gates + (t == H1 ? (size_t)0 : (size_t)T * DM); const unsigned char* gb = ga + (size_t)T * DM;
        u32x2 av[2][4][2], bv[2][4][2];
#pragma unroll
        for (int ai = 0; ai < 2; ++ai)
#pragma unroll
            for (int m = 0; m < 4; ++m)
#pragma unroll
                for (int bj = 0; bj < 2; ++bj) { const size_t o = (size_t)(row0 + ai * HALF + m * 16) * DM + u.pn * BM + bj * HALF + wc * 32 + 8 * fq;
                    av[ai][m][bj] = *(const u32x2*)(ga + o); bv[ai][m][bj] = *(const u32x2*)(gb + o); }
#pragma unroll
        for (int ai = 0; ai < 2; ++ai)
#pragma unroll
            for (int m = 0; m < 4; ++m)
#pragma unroll
                for (int bj = 0; bj < 2; ++bj)
#pragma unroll
                    for (int e = 0; e < 8; ++e) { const unsigned wa = e < 4 ? av[ai][m][bj].x : av[ai][m][bj].y, wb = e < 4 ? bv[ai][m][bj].x : bv[ai][m][bj].y;
                        const float fa = (float)((wa >> (8 * (e & 3))) & 255u), fb = (float)((wb >> (8 * (e & 3))) & 255u);
                        acc[ai][bj][m][e >> 2][e & 3] *= fa * __builtin_amdgcn_rcpf(fb); }
    }
    __device__ __forceinline__ void operator()(const Acc& acc, const Unit& u, int wr, int wc, int fr, int fq) const {
        const int row0 = u.pm * BM + wr * 64 + fr; const unsigned char* g2 = (const unsigned char*)gates + (size_t)2 * T * DM;
        u32x2 gv[2][4][2];
#pragma unroll
        for (int ai = 0; ai < 2; ++ai)
#pragma unroll
            for (int m = 0; m < 4; ++m)
#pragma unroll
                for (int bj = 0; bj < 2; ++bj) gv[ai][m][bj] = *(const u32x2*)(g2 + (size_t)(row0 + ai * HALF + m * 16) * DM + u.pn * BM + bj * HALF + wc * 32 + 8 * fq);
#pragma unroll
        for (int ai = 0; ai < 2; ++ai)
#pragma unroll
            for (int m = 0; m < 4; ++m) { const int r = row0 + ai * HALF + m * 16;
#pragma unroll
                for (int bj = 0; bj < 2; ++bj) { const size_t o = (size_t)r * DM + u.pn * BM + bj * HALF + wc * 32 + 8 * fq;
                    f32x4 v0 = acc[ai][bj][m][0], v1 = acc[ai][bj][m][1];
#pragma unroll
                    for (int i = 0; i < 4; ++i) { v0[i] *= (float)((gv[ai][m][bj].x >> (8 * i)) & 255u) * (1.f / 255.f); v1[i] *= (float)((gv[ai][m][bj].y >> (8 * i)) & 255u) * (1.f / 255.f); }
                    *(u32x4*)(out + o) = pack8(v0, v1); } }
    }
};

struct BranchOrder {
    StaticOrder base;
    __host__ __device__ void init(int M, int N, int G_, int c_) { base.init(M, N, G_, c_); }
    __host__ __device__ bool next(int i, Unit& u) const { if (!base.next(i >> 2, u)) return false; u.ko = 512 * (i & 3); return true; }
};
struct Epi2b {
    static constexpr bool PERM = true, HOOK = false; static constexpr int H1 = -1, H2 = -1;
    const bf16_t* gates; bf16_t* out;
    __device__ __forceinline__ void operator()(const Acc& acc, const Unit& u, int wr, int wc, int fr, int fq) const {
        const int row0 = u.pm * BM + wr * 64 + fr, sl = u.ko >> 9; const bf16_t* gp = gates + (size_t)(sl < 2 ? sl : 2) * T * DM;
#pragma unroll
        for (int ai = 0; ai < 2; ++ai) {
            bf16x8 gv[4][2], pv[4][2];
#pragma unroll
            for (int m = 0; m < 4; ++m)
#pragma unroll
                for (int bj = 0; bj < 2; ++bj) { const size_t o = (size_t)(row0 + ai * HALF + m * 16) * DM + u.pn * BM + bj * HALF + wc * 32 + 8 * fq;
                    gv[m][bj] = *(const bf16x8*)(gp + o); if (sl) pv[m][bj] = *(const bf16x8*)(out + o); }
#pragma unroll
            for (int m = 0; m < 4; ++m)
#pragma unroll
                for (int bj = 0; bj < 2; ++bj) { const size_t o = (size_t)(row0 + ai * HALF + m * 16) * DM + u.pn * BM + bj * HALF + wc * 32 + 8 * fq;
                    f32x4 v0 = acc[ai][bj][m][0], v1 = acc[ai][bj][m][1];
#pragma unroll
                    for (int i = 0; i < 4; ++i) { v0[i] *= bf2f((bf16_t)gv[m][bj][i]); v1[i] *= bf2f((bf16_t)gv[m][bj][4 + i]); }
                    if (sl) {
#pragma unroll
                        for (int i = 0; i < 4; ++i) { v0[i] += bf2f((bf16_t)pv[m][bj][i]); v1[i] += bf2f((bf16_t)pv[m][bj][4 + i]); } }
                    *(u32x4*)(out + o) = pack8(v0, v1); }
            __builtin_amdgcn_sched_barrier(0);
        }
    }
};

struct EpiF32 {
    static constexpr bool PERM = false, HOOK = false; static constexpr int H1 = -1, H2 = -1;
    float* C; int ldc; int pad;
    __device__ __forceinline__ void operator()(const Acc& acc, const Unit& u, int wr, int wc, int fr, int fq) const {
        const int row0 = u.pm * BM + wr * 64 + fr, col0 = u.pn * BM + wc * 32 + 4 * fq;
#pragma unroll
        for (int ai = 0; ai < 2; ++ai)
#pragma unroll
            for (int m = 0; m < 4; ++m) { float* rowp = C + (size_t)(row0 + ai * HALF + m * 16) * ldc + col0;
#pragma unroll
                for (int bj = 0; bj < 2; ++bj)
#pragma unroll
                    for (int n = 0; n < 2; ++n) *(f32x4*)(rowp + bj * HALF + n * 16) = acc[ai][bj][m][n]; }
    }
};

struct EpiBf16P {
    static constexpr bool PERM = true, HOOK = false; static constexpr int H1 = -1, H2 = -1;
    bf16_t* C; int ldc; int pad;
    __device__ __forceinline__ void operator()(const Acc& acc, const Unit& u, int wr, int wc, int fr, int fq) const {
        const int row0 = u.pm * BM + wr * 64 + fr, col0 = u.pn * BM + wc * 32 + 8 * fq;
#pragma unroll
        for (int ai = 0; ai < 2; ++ai)
#pragma unroll
            for (int m = 0; m < 4; ++m) { bf16_t* rowp = C + (size_t)(row0 + ai * HALF + m * 16) * ldc + col0;
#pragma unroll
                for (int bj = 0; bj < 2; ++bj) *(u32x4*)(rowp + bj * HALF) = pack8(acc[ai][bj][m][0], acc[ai][bj][m][1]); }
    }
};

struct EpiSwiGLU {
    static constexpr bool PERM = true, HOOK = false; static constexpr int H1 = -1, H2 = -1;
    bf16_t* hid; const float* rstd;
    __device__ __forceinline__ void operator()(const Acc& acc, const Unit& u, int wr, int wc, int fr, int fq) const {
        const int row0 = u.pm * BM + wr * 64 + fr;
#pragma unroll
        for (int ai = 0; ai < 2; ++ai)
#pragma unroll
            for (int m = 0; m < 4; ++m) { const int r = row0 + ai * HALF + m * 16;
#pragma unroll
                for (int bj = 0; bj < 2; ++bj) { const f32x4 gt = acc[ai][bj][m][0], up = acc[ai][bj][m][1]; float h[4];
#pragma unroll
                    for (int i = 0; i < 4; ++i) h[i] = gt[i] * sigmoidf_(gt[i]) * up[i];
                    u32x2 w; w.x = cvt_pk_bf16(h[0], h[1]); w.y = cvt_pk_bf16(h[2], h[3]);
                    *(u32x2*)(hid + (size_t)r * DFF + u.pn * 128 + bj * 64 + wc * 16 + 4 * fq) = w; } }
    }
};

struct EpiC1 {
    static constexpr bool PERM = true, HOOK = false; static constexpr int H1 = -1, H2 = -1;
    bf16_t* h1; const float* posb;
    __device__ __forceinline__ void operator()(const Acc& acc, const Unit& u, int wr, int wc, int fr, int fq) const {
        const int row0 = u.pm * BM + wr * 64 + fr;
#pragma unroll
        for (int ai = 0; ai < 2; ++ai)
#pragma unroll
            for (int m = 0; m < 4; ++m) { const int r = row0 + ai * HALF + m * 16;
#pragma unroll
                for (int bj = 0; bj < 2; ++bj) { const int col = bj * HALF + wc * 32 + 8 * fq; const float* pb = posb + u.pn * 256 + col;
                    f32x4 v0 = acc[ai][bj][m][0], v1 = acc[ai][bj][m][1];
#pragma unroll
                    for (int i = 0; i < 4; ++i) { const float a = v0[i] + pb[i], b = v1[i] + pb[4 + i]; v0[i] = a * sigmoidf_(a); v1[i] = b * sigmoidf_(b); }
                    *(u32x4*)(h1 + (size_t)r * 256 + col) = pack8(v0, v1); } }
    }
};
}


__device__ __forceinline__ int colmap(int mode, int n) {
    if (mode == 0) return n;
    if (mode == 1) {
        if (n < 1536) return n;
        if (n < 5632) return n + 4;
        const int j = n - 5632;
        if (j < 4) return 1536 + j;
        if (j < 28) return 5636 + (j - 4);
        return -1;
    }
    const int q = n >> 3, i = n & 7;
    return i < 4 ? 4 * q + i : DFF + 4 * q + (i - 4);
}

namespace att {
constexpr int KT = 16384, VT = 16384, KAT = 1024, STG = KT + VT + KAT;
constexpr int L_X3 = 3 * STG, L_X2 = 2 * STG;
constexpr int LDS_ATT_TOTAL = 147456;
constexpr int L_SLOT = LDS_ATT_TOTAL - 64, L_T0S = LDS_ATT_TOTAL - 96, L_BARW = LDS_ATT_TOTAL - 32;
constexpr float LOG2E = 1.4426950408889634f;
constexpr float NEG_INF = -__builtin_inff();
__device__ __forceinline__ int crow(int i, int hi) { return (i & 3) + 8 * (i >> 2) + 4 * hi; }

struct DmaOff { unsigned k[2], v[2]; };
__device__ __forceinline__ DmaOff dma_offsets(int wv, int lane) {
    DmaOff d;
#pragma unroll
    for (int ii = 0; ii < 2; ++ii) { const int row = 4 * (2 * wv + ii) + (lane >> 4), p = lane & 15;
        d.k[ii] = (unsigned)(row * 128 + ((p ^ (row & 15)) << 3)); d.v[ii] = (unsigned)(row * 128 + ((p ^ ((row & 3) << 2)) << 3)); }
    return d;
}
__device__ __forceinline__ void dma_tile(LAS unsigned char* sbase, const bf16_t* Kg, const bf16_t* Vg, int key0, const DmaOff& d, int wv) {
#pragma unroll
    for (int ii = 0; ii < 2; ++ii) {
        __builtin_amdgcn_global_load_lds((const unsigned*)(Kg + (size_t)key0 * HD + d.k[ii]), (LAS unsigned*)(sbase + (2 * wv + ii) * 1024), 16, 0, 0);
        __builtin_amdgcn_global_load_lds((const unsigned*)(Vg + (size_t)key0 * HD + d.v[ii]), (LAS unsigned*)(sbase + KT + (2 * wv + ii) * 1024), 16, 0, 0); }
}
__device__ __forceinline__ int kaddr(int lane, int c) { return (lane & 31) * 256 + ((c ^ (lane & 15)) << 4); }
__device__ __forceinline__ int vaddr(int lane, int dblk) { const int q = (lane >> 2) & 3;
    return (4 * (lane >> 5) + q) * 256 + ((dblk ^ q) << 6) + (((lane >> 4) & 1) << 5) + (((lane & 3) >> 1) << 4) + ((lane & 1) << 3); }
__device__ __forceinline__ unsigned pack_hilo(float x) { const float h = __uint_as_float(cvt_pk_bf16(x, 0.f) << 16); return cvt_pk_bf16(h, x - h); }
__device__ __forceinline__ bf16x8 make_qaug(float a0, float a1, int hi) {
    u32x4 w = {pack_hilo(a0), pack_hilo(a1), 0u, 0u}; if (hi) w = (u32x4){0u, 0u, 0u, 0u};
    return *reinterpret_cast<bf16x8*>(&w);
}
__device__ __forceinline__ void load_q(bf16x8* qf, const bf16_t* qrow, int hi) {
#pragma unroll
    for (int s = 0; s < 8; ++s) qf[s] = *(const bf16x8*)(qrow + 16 * s + 8 * hi);
}
template <int NS, bool AUG>
__device__ __forceinline__ void qk_tile(f32x16& p0, f32x16& p1, const LAS unsigned char* sb, const int* ka, int kaa, const bf16x8* qf, const bf16x8 qaug) {
#pragma unroll
    for (int i = 0; i < 16; ++i) { p0[i] = 0.f; p1[i] = 0.f; }
    constexpr int NG = NS / 2;
    bf16x8 kf[2][4];
#define QK_LOAD(g, par) do { kf[par][0] = *(const LAS bf16x8*)(sb + ka[2 * (g)]); kf[par][1] = *(const LAS bf16x8*)(sb + ka[2 * (g)] + 8192); \
        kf[par][2] = *(const LAS bf16x8*)(sb + ka[2 * (g) + 1]); kf[par][3] = *(const LAS bf16x8*)(sb + ka[2 * (g) + 1] + 8192); } while (0)
    QK_LOAD(0, 0);
#pragma unroll
    for (int g = 0; g < NG; ++g) {
        if (g + 1 < NG) QK_LOAD(g + 1, (g + 1) & 1);
        p0 = __builtin_amdgcn_mfma_f32_32x32x16_bf16(kf[g & 1][0], qf[2 * g], p0, 0, 0, 0);
        p1 = __builtin_amdgcn_mfma_f32_32x32x16_bf16(kf[g & 1][1], qf[2 * g], p1, 0, 0, 0);
        p0 = __builtin_amdgcn_mfma_f32_32x32x16_bf16(kf[g & 1][2], qf[2 * g + 1], p0, 0, 0, 0);
        p1 = __builtin_amdgcn_mfma_f32_32x32x16_bf16(kf[g & 1][3], qf[2 * g + 1], p1, 0, 0, 0);
        __builtin_amdgcn_sched_barrier(0);
    }
    if (AUG) {
        const bf16x8 a0 = *(const LAS bf16x8*)(sb + KT + VT + kaa), a1 = *(const LAS bf16x8*)(sb + KT + VT + kaa + 512);
        p0 = __builtin_amdgcn_mfma_f32_32x32x16_bf16(a0, qaug, p0, 0, 0, 0);
        p1 = __builtin_amdgcn_mfma_f32_32x32x16_bf16(a1, qaug, p1, 0, 0, 0);
    }
#undef QK_LOAD
}
__device__ __forceinline__ void softmax_step(f32x16& p0, f32x16& p1, float& m, float& l, f32x16* o, const float sc2) {
    float mx = fmaxf(p0[0], p1[0]);
#pragma unroll
    for (int i = 1; i < 16; ++i) mx = fmaxf(mx, fmaxf(p0[i], p1[i]));
    { auto rr = __builtin_amdgcn_permlane32_swap(__float_as_uint(mx), __float_as_uint(mx), false, false); mx = fmaxf(__uint_as_float(rr[0]), __uint_as_float(rr[1])); }
    constexpr float THR2 = 11.0f;
    if (!__all((mx - m) * sc2 <= THR2)) { const float mn = fmaxf(m, mx); const float alpha = __builtin_amdgcn_exp2f((m - mn) * sc2); l *= alpha;
#pragma unroll
        for (int d = 0; d < 4; ++d)
#pragma unroll
            for (int i = 0; i < 16; ++i) o[d][i] *= alpha;
        m = mn; }
    const float nm = -m * sc2;
    float ps = 0.f;
#pragma unroll
    for (int i = 0; i < 16; ++i) { p0[i] = __builtin_amdgcn_exp2f(fmaf(p0[i], sc2, nm)); p1[i] = __builtin_amdgcn_exp2f(fmaf(p1[i], sc2, nm)); ps += p0[i] + p1[i]; }
    l += ps;
}
__device__ __forceinline__ bf16x8 pfrag(const f32x16& p, int s) {
    u32x4 w; w.x = cvt_pk_bf16(p[8 * s + 0], p[8 * s + 1]); w.y = cvt_pk_bf16(p[8 * s + 2], p[8 * s + 3]); w.z = cvt_pk_bf16(p[8 * s + 4], p[8 * s + 5]); w.w = cvt_pk_bf16(p[8 * s + 6], p[8 * s + 7]);
    return *reinterpret_cast<bf16x8*>(&w);
}
__device__ __forceinline__ void pv_tile(f32x16* o, const LAS unsigned char* sb, const int* va, const f32x16& p0, const f32x16& p1) {
    bf16x8 pf[4]; pf[0] = pfrag(p0, 0); pf[1] = pfrag(p0, 1); pf[2] = pfrag(p1, 0); pf[3] = pfrag(p1, 1);
    s16x4 vl[2][4], vh[2][4];
#define PV_LOAD(d, par) do { _Pragma("unroll") for (int ks = 0; ks < 4; ++ks) { const LAS unsigned char* a_ = sb + KT + va[d] + 4096 * ks; \
        vl[par][ks] = __builtin_amdgcn_ds_read_tr16_b64_v4i16((LAS s16x4*)a_); vh[par][ks] = __builtin_amdgcn_ds_read_tr16_b64_v4i16((LAS s16x4*)(a_ + 2048)); } } while (0)
    PV_LOAD(0, 0);
#pragma unroll
    for (int d = 0; d < 4; ++d) {
        if (d + 1 < 4) PV_LOAD(d + 1, (d + 1) & 1);
#pragma unroll
        for (int ks = 0; ks < 4; ++ks) {
            const s16x4 lo = vl[d & 1][ks], hh = vh[d & 1][ks];
            const bf16x8 vf = {lo[0], lo[1], lo[2], lo[3], hh[0], hh[1], hh[2], hh[3]};
            o[d] = __builtin_amdgcn_mfma_f32_32x32x16_bf16(vf, pf[ks], o[d], 0, 0, 0);
        }
        __builtin_amdgcn_sched_barrier(0);
    }
#undef PV_LOAD
}
__device__ __forceinline__ float half_sum(float v) { auto rr = __builtin_amdgcn_permlane32_swap(__float_as_uint(v), __float_as_uint(v), false, false); return __uint_as_float(rr[0]) + __uint_as_float(rr[1]); }

__device__ __forceinline__ int queue_next(unsigned* ctr, LAS int* slot, const int wv) {
    __syncthreads();
    if (TID_OPAQUE(wv) == 0) { unsigned long long ca = (unsigned long long)ctr; asm volatile("" : "+s"(ca));
        *slot = (int)__hip_atomic_fetch_add((unsigned*)ca, 1u, __ATOMIC_RELAXED, __HIP_MEMORY_SCOPE_AGENT); }
    __syncthreads();
    return *slot;
}

template <int NSTG, bool CUM, class KF, class DJF, class BODY>
__device__ __forceinline__ void tile_loop(int NT, LAS unsigned char* lds, const bf16_t* Kg, const bf16_t* Vg, const float* cm, int tid, int wv, const KF& kf, const DJF& djf, const BODY& body) {
    const int lane = tid & 63;
    const DmaOff dof = dma_offsets(wv, lane);
#define TL_ISSUE(i, stg) do { const int i_ = (i) < NT ? (i) : NT - 1; const int k0_ = kf(i_); LAS unsigned char* sb_ = lds + (stg) * STG; dma_tile(sb_, Kg, Vg, k0_, dof, wv); \
        if (CUM) { if (wv == 0) __builtin_amdgcn_global_load_lds((const unsigned*)(cm + k0_ + lane), (LAS unsigned*)(sb_ + KT + VT), 4, 0, 0); } \
        else if (tid < 64) { const float fr_ = (float)tid, dj_ = djf(i_); *(LAS u32x4*)(sb_ + KT + VT + tid * 16) = (u32x4){cvt_pk_bf16(fr_, fr_), cvt_pk_bf16(dj_, dj_), 0u, 0u}; } } while (0)
#define TL_WAIT() do { if (NSTG == 3) asm volatile("s_waitcnt vmcnt(4) lgkmcnt(0)" ::: "memory"); else asm volatile("s_waitcnt vmcnt(0) lgkmcnt(0)" ::: "memory"); \
        __builtin_amdgcn_s_barrier(); asm volatile("" ::: "memory"); } while (0)
    TL_ISSUE(0, 0);
    if (NSTG == 3) TL_ISSUE(1, 1);
    TL_WAIT();
    if (NSTG == 3) {
        for (int t = 0; t < NT; t += 3) {
            TL_ISSUE(t + 2, 2); body(t, lds); TL_WAIT();
            if (t + 1 >= NT) break;
            TL_ISSUE(t + 3, 0); body(t + 1, lds + STG); TL_WAIT();
            if (t + 2 >= NT) break;
            TL_ISSUE(t + 4, 1); body(t + 2, lds + 2 * STG); TL_WAIT();
        }
    } else {
        for (int t = 0; t < NT; t += 2) {
            TL_ISSUE(t + 1, 1); body(t, lds); TL_WAIT();
            if (t + 1 >= NT) break;
            TL_ISSUE(t + 2, 0); body(t + 1, lds + STG); TL_WAIT();
        }
    }
    asm volatile("s_waitcnt vmcnt(0)" ::: "memory"); __builtin_amdgcn_s_barrier(); asm volatile("" ::: "memory");
#undef TL_ISSUE
#undef TL_WAIT
}

__device__ __forceinline__ void fox_item(int bh, int xb, LAS unsigned char* lds, const bf16_t* qkv, const float* cum, const unsigned* kbound, bf16_t* attb, const int wv) {
    const int tid = TID_OPAQUE(wv);
    const int wid = wv, lane = tid & 63, r32 = lane & 31, hi = lane >> 5;
    const int b = bh >> 2, h = bh & 3, q0 = xb * 256, qw = q0 + 32 * wid, qi = qw + r32;
    const bf16_t* Qg = qkv + ((size_t)((SL_FQ + h) * 4 + b) * SEQ) * HD; const bf16_t* Kg = qkv + ((size_t)((SL_FK + h) * 4 + b) * SEQ) * HD; const bf16_t* Vg = qkv + ((size_t)((SL_FV + h) * 4 + b) * SEQ) * HD;
    const float* cm = cum + (size_t)bh * SEQ;
    bf16x8 qf[8]; load_q(qf, Qg + (size_t)qi * HD, hi);
    bf16x8 qaug; { u32x4 w = {0u, 0u, 0u, 0u}; qaug = *reinterpret_cast<bf16x8*>(&w); }
    const int NT = 4 * (xb + 1);
    int ka[8], va[4];
#pragma unroll
    for (int s = 0; s < 8; ++s) ka[s] = kaddr(lane, 2 * s + hi);
#pragma unroll
    for (int d = 0; d < 4; ++d) va[d] = vaddr(lane, d);
    f32x16 o[4];
#pragma unroll
    for (int d = 0; d < 4; ++d)
#pragma unroll
        for (int i = 0; i < 16; ++i) o[d][i] = 0.f;
    float m = -1e30f, l = 0.f;
    constexpr float SCN = 0.08838834764831845f, SC2 = SCN * LOG2E, CINV = 1.0f / SCN;
    const float cq0 = cm[q0];
    int t0w;
    { float qs = 0.f;
#pragma unroll
      for (int s = 0; s < 8; ++s)
#pragma unroll
          for (int e = 0; e < 8; ++e) { const float v = bf2f((bf16_t)qf[s][e]); qs = fmaf(v, v, qs); }
      qs = wave_max(half_sum(qs));
      const unsigned* kb = kbound + 2048 + (h * 4 + b) * 16;
      float ks = 0.f;
#pragma unroll
      for (int pp = 0; pp < 16; ++pp) ks += __uint_as_float(kb[pp]);
      const float bound = 2.0f * 1.02f * (0.08838834764831845f * LOG2E) * sqrtf(qs * ks);
      const float ce = lane < NT ? cm[64 * lane + 63] : cm[qw];
      const bool useful = (cm[qw] - ce) * LOG2E + bound >= -36.0f || lane >= NT - 1;
      const unsigned long long bl = __ballot(useful);
      t0w = (int)__builtin_ctzll(bl); if (t0w > NT - 1) t0w = NT - 1; }
    LAS int* t0s = (LAS int*)(lds + L_T0S);
    if (tid == 0) *t0s = NT;
    __syncthreads();
    if (lane == 0) __hip_atomic_fetch_min(t0s, t0w, __ATOMIC_RELAXED, __HIP_MEMORY_SCOPE_WORKGROUP);
    __syncthreads();
    const int t0 = *t0s;
    auto kf = [&](int i) { return 64 * (i + t0); };
    auto djf = [&](int) { return 0.f; };
    auto body = [&](int ti, LAS unsigned char* sb) {
        const int t = ti + t0, key0 = 64 * t;
        if (key0 <= qw + 31 && t >= t0w) {
            f32x16 p0, p1;
            qk_tile<8, false>(p0, p1, sb, ka, 0, qf, qaug);
            const LAS float* cb = (const LAS float*)(sb + KT + VT);
#pragma unroll
            for (int g = 0; g < 4; ++g) {
                const f32x4 c0 = *(const LAS f32x4*)(cb + 8 * g + 4 * hi), c1 = *(const LAS f32x4*)(cb + 32 + 8 * g + 4 * hi);
#pragma unroll
                for (int e = 0; e < 4; ++e) { const int i = 4 * g + e; p0[i] = fmaf(cq0 - c0[e], CINV, p0[i]); p1[i] = fmaf(cq0 - c1[e], CINV, p1[i]); }
            }
            if (key0 + 63 > qw) {
                asm volatile("; masked tile: keep this a real branch (rare path)");
                const int dq = qi - key0 - 4 * hi;
#pragma unroll
                for (int i = 0; i < 16; ++i) { const int c = (i & 3) + 8 * (i >> 2); p0[i] = c > dq ? NEG_INF : p0[i]; p1[i] = c + 32 > dq ? NEG_INF : p1[i]; }
            }
            softmax_step(p0, p1, m, l, o, SC2);
            pv_tile(o, sb, va, p0, p1);
        }
    };
    tile_loop<3, true>(NT - t0, lds, Kg, Vg, cm, tid, wv, kf, djf, body);
    const float inv = 1.0f / half_sum(l);
    bf16_t* orow = attb + ((size_t)(b * SEQ + qi)) * DM + h * HD;
#pragma unroll
    for (int d = 0; d < 4; ++d)
#pragma unroll
        for (int g = 0; g < 4; ++g) { u32x2 w; w.x = cvt_pk_bf16(o[d][4 * g] * inv, o[d][4 * g + 1] * inv); w.y = cvt_pk_bf16(o[d][4 * g + 2] * inv, o[d][4 * g + 3] * inv);
            *(u32x2*)(orow + 32 * d + 8 * g + 4 * hi) = w; }
}

__device__ __forceinline__ void diff_map_step(f32x16* o, float& m, float& l, const LAS unsigned char* sb, const int* ka, int kaa, const int* va, const bf16x8* qf, const bf16x8 qaug,
                                              bool needmask, int dq  ) {
    f32x16 p0, p1;
    qk_tile<4, true>(p0, p1, sb, ka, kaa, qf, qaug);
    if (needmask) {
        asm volatile("; masked tile: keep this a real branch (rare path)");
#pragma unroll
        for (int i = 0; i < 16; ++i) { const int c = (i & 3) + 8 * (i >> 2); p0[i] = c > dq ? NEG_INF : p0[i]; p1[i] = c + 32 > dq ? NEG_INF : p1[i]; } }
    softmax_step(p0, p1, m, l, o, 0.125f * LOG2E);
    pv_tile(o, sb, va, p0, p1);
}
constexpr int L_DX = 0;
__device__ __forceinline__ void diff_item(int bh, int xb, LAS unsigned char* lds, const bf16_t* qkv, const unsigned* kbound, const float* lamv, const float* subln, float lam_init, float oml, bf16_t* attb, const int wv) {
    const int tid = TID_OPAQUE(wv);
    const int wid = wv, lane = tid & 63, r32 = lane & 31, hi = lane >> 5, rw = wid & 3, mp = wid >> 2;
    const int b = bh >> 2, h = bh & 3, q0 = xb * 128, qw = q0 + 32 * rw, qi = qw + r32;
    const bf16_t* Qg = qkv + ((size_t)((SL_DQ + h) * 4 + b) * SEQ) * HD; const bf16_t* Kg = qkv + ((size_t)((SL_DK + h) * 4 + b) * SEQ) * HD; const bf16_t* Vg = qkv + ((size_t)((SL_DV + h) * 4 + b) * SEQ) * HD;
    bf16x8 qf[4];
#pragma unroll
    for (int s = 0; s < 4; ++s) qf[s] = *(const bf16x8*)(Qg + (size_t)qi * HD + 64 * mp + 16 * s + 8 * hi);
    const float a0 = exp2f(-2.0f * (float)(h + 1)) * 8.0f;
    const bf16x8 qaug = make_qaug(a0, 64.0f * a0, hi);
    const int NTall = 2 * (xb + 1), j0 = 2 * xb;
    int ka[4], va[4]; const int kaa = r32 * 16;
#pragma unroll
    for (int s = 0; s < 4; ++s) ka[s] = kaddr(lane, 2 * s + hi + 8 * mp);
#pragma unroll
    for (int d = 0; d < 4; ++d) va[d] = vaddr(lane, d);
    int t0w;
    { float qs = 0.f;
#pragma unroll
      for (int s = 0; s < 4; ++s)
#pragma unroll
          for (int e = 0; e < 8; ++e) { const float v = bf2f((bf16_t)qf[s][e]); qs = fmaf(v, v, qs); }
      qs = wave_max(half_sum(qs));
      float ks = 0.f;
#pragma unroll
      for (int pp = 0; pp < 8; ++pp) ks += __uint_as_float(kbound[(h * 4 + b) * 16 + 8 * mp + pp]);
      const float bound = 2.0f * sqrtf(qs * ks) * 1.02f * (0.125f * LOG2E);
      const float X = (36.0f + bound) / (exp2f(-2.0f * (float)(h + 1)) * LOG2E);
      const float v = ((float)(qw - 63) - X) * (1.0f / 64.0f);
      t0w = v > 0.f ? (int)ceilf(v) : 0; if (t0w > NTall - 1) t0w = NTall - 1; }
    LAS int* t0s = (LAS int*)(lds + L_T0S);
    if (tid == 0) *t0s = NTall;
    __syncthreads();
    if (lane == 0) __hip_atomic_fetch_min(t0s, t0w, __ATOMIC_RELAXED, __HIP_MEMORY_SCOPE_WORKGROUP);
    __syncthreads();
    const int t0 = *t0s, NT = NTall - t0;
    f32x16 o[4];
#pragma unroll
    for (int d = 0; d < 4; ++d)
#pragma unroll
        for (int i = 0; i < 16; ++i) o[d][i] = 0.f;
    float m = -1e30f, l = 0.f;
    auto kf = [&](int i) { return 64 * (i + t0); };
    auto djf = [&](int i) { return (float)(i + t0 - j0); };
    auto body = [&](int ti, LAS unsigned char* sb) {
        const int t = ti + t0, key0 = 64 * t;
        if (key0 <= qw + 31 && t >= t0w) {
            const bool needmask = key0 + 63 > qw; const int dq = qi - key0 - 4 * hi;
            diff_map_step(o, m, l, sb, ka, kaa, va, qf, qaug, needmask, dq);
        }
    };
    tile_loop<3, false>(NT, lds, Kg, Vg, (const float*)nullptr, tid, wv, kf, djf, body);
    const float la = wave_sum(lamv[lane] * lamv[64 + lane]), lb = wave_sum(lamv[128 + lane] * lamv[192 + lane]);
    const float lam = expf(la) - expf(lb) + lam_init;
    LAS float* xw = (LAS float*)(lds + L_DX) + rw * 4096 + lane;
    const float inv = (mp == 0 ? 1.0f : lam) / half_sum(l);
    if (mp == 1) {
#pragma unroll
        for (int d = 0; d < 4; ++d)
#pragma unroll
            for (int i = 0; i < 16; ++i) xw[(d * 16 + i) * 64] = o[d][i] * inv;
    }
    __syncthreads();
    if (mp == 0) {
        float ss = 0.f;
#pragma unroll
        for (int d = 0; d < 4; ++d)
#pragma unroll
            for (int i = 0; i < 16; ++i) { const float v = o[d][i] * inv - xw[(d * 16 + i) * 64]; o[d][i] = v; ss = fmaf(v, v, ss); if (i == 15) __builtin_amdgcn_sched_barrier(0); }
        ss = half_sum(ss);
        const float rn = rsqrtf(ss * (1.f / 128.f) + EPS) * oml;
        bf16_t* orow = attb + ((size_t)(b * SEQ + qi)) * DM + 512 + h * HD;
#pragma unroll
        for (int d = 0; d < 4; ++d)
#pragma unroll
            for (int g = 0; g < 4; ++g) { const f32x4 sg = *(const f32x4*)(subln + 32 * d + 8 * g + 4 * hi);
                u32x2 w; w.x = cvt_pk_bf16(o[d][4 * g] * rn * sg[0], o[d][4 * g + 1] * rn * sg[1]); w.y = cvt_pk_bf16(o[d][4 * g + 2] * rn * sg[2], o[d][4 * g + 3] * rn * sg[3]);
                *(u32x2*)(orow + 32 * d + 8 * g + 4 * hi) = w; if (g == 3) __builtin_amdgcn_sched_barrier(0); }
    }
}

constexpr int L_NS = L_X2 + 1024;
constexpr int L_SM = L_NS + 65536;
constexpr int L_UM = L_SM + 512;
constexpr int L_TL = L_UM + 128;
constexpr int L_SC = L_TL + 64;
constexpr int NSA_END = L_SC + 1024;
constexpr int L_V2 = 0;

__device__ __forceinline__ void softmax_stats(const f32x16& p0, const f32x16& p1, float& m, float& l, const float sc2) {
    float mx = fmaxf(p0[0], p1[0]);
#pragma unroll
    for (int i = 1; i < 16; ++i) mx = fmaxf(mx, fmaxf(p0[i], p1[i]));
    { auto rr = __builtin_amdgcn_permlane32_swap(__float_as_uint(mx), __float_as_uint(mx), false, false); mx = fmaxf(__uint_as_float(rr[0]), __uint_as_float(rr[1])); }
    const float mn = fmaxf(m, mx), nm = -mn * sc2;
    float ps = 0.f;
#pragma unroll
    for (int i = 0; i < 16; ++i) ps += __builtin_amdgcn_exp2f(fmaf(p0[i], sc2, nm)) + __builtin_amdgcn_exp2f(fmaf(p1[i], sc2, nm));
    l = l * __builtin_amdgcn_exp2f((m - mn) * sc2) + ps; m = mn;
}
__device__ __forceinline__ int ctz64(unsigned long long x) { return __builtin_ctzll(x); }

template <class XF, class POST>
__device__ __forceinline__ void nsa_branch(LAS unsigned char* lds, const bf16_t* Kg, const bf16_t* Vg, unsigned long long tiles, unsigned long long wact, int j0,
                                           const bf16x8* qf, const bf16x8 qaug, const int* ka, int kaa, const int* va, int tid, int wv, float gate, f32x16* o, const XF& xf, const POST& post) {
    if (tiles == 0ull) return;
    constexpr float SC2 = 0.08838834764831845f * LOG2E;
    LAS unsigned char* tl = lds + L_TL;
    if (tid == 0) { unsigned long long bits = tiles; int n = 0; while (bits) { tl[n++] = (unsigned char)ctz64(bits); bits &= bits - 1; } }
    const int NT = __builtin_popcountll(tiles);
    __syncthreads();
    float m = -1e30f, l = 0.f;
    auto kf = [&](int i) { return 64 * (int)tl[i]; };
    auto djf = [&](int i) { return (float)((int)tl[i] - j0); };
    auto bodyA = [&](int t, LAS unsigned char* sb) { const int j = (int)__builtin_amdgcn_readfirstlane((int)tl[t]);
        if ((wact >> j) & 1ull) { f32x16 p0, p1; qk_tile<8, true>(p0, p1, sb, ka, kaa, qf, qaug); xf(p0, p1, j); softmax_stats(p0, p1, m, l, SC2); } };
    tile_loop<2, false>(NT, lds, Kg, Vg, (const float*)nullptr, tid, wv, kf, djf, bodyA);
    const float lt = half_sum(l);
    const float scl = lt > 0.f ? 1.0f / lt : 0.f;
    const float nm = -m * SC2;
    auto bodyB = [&](int t, LAS unsigned char* sb) { const int j = (int)__builtin_amdgcn_readfirstlane((int)tl[t]);
        if ((wact >> j) & 1ull) { f32x16 p0, p1; qk_tile<8, true>(p0, p1, sb, ka, kaa, qf, qaug); xf(p0, p1, j);
#pragma unroll
            for (int i = 0; i < 16; ++i) { p0[i] = __builtin_amdgcn_exp2f(fmaf(p0[i], SC2, nm)) * scl; p1[i] = __builtin_amdgcn_exp2f(fmaf(p1[i], SC2, nm)) * scl; }
            post(p0, p1, j);
#pragma unroll
            for (int i = 0; i < 16; ++i) { p0[i] *= gate; p1[i] *= gate; }
            pv_tile(o, sb, va, p0, p1); } };
    tile_loop<2, false>(NT, lds, Kg, Vg, (const float*)nullptr, tid, wv, kf, djf, bodyB);
}

template <class XF, class POST>
__device__ __forceinline__ void nsa_branch_cmp(LAS unsigned char* lds, const bf16_t* Kg, const bf16_t* Vg, unsigned long long tiles, unsigned long long wact, int j0,
                                               const bf16x8* qf, const bf16x8 qaug, const int* ka, int kaa, const int* va, int tid, int wv, float gate, f32x16* o,
                                               LAS float* imprh, LAS float* sclw, const XF& xf, const POST& post) {
    constexpr float SC2 = 0.08838834764831845f * LOG2E;
    LAS unsigned char* tl = lds + L_TL;
    const int NT = __builtin_popcountll(tiles);
    if (tid == 0) { unsigned long long bits = tiles; int n = NT; while (bits) { tl[--n] = (unsigned char)ctz64(bits); bits &= bits - 1; } }
    __syncthreads();
    float m = -1e30f, l = 0.f;
    auto kf = [&](int i) { return 64 * (int)tl[i]; };
    auto djf = [&](int i) { return (float)((int)tl[i] - j0); };
    auto body = [&](int t, LAS unsigned char* sb) { const int j = (int)__builtin_amdgcn_readfirstlane((int)tl[t]);
        if ((wact >> j) & 1ull) { f32x16 p0, p1; qk_tile<8, true>(p0, p1, sb, ka, kaa, qf, qaug); xf(p0, p1, j);
            const float mold = m;
            softmax_step(p0, p1, m, l, o, SC2);
            if (__any(m != mold && mold > -1e29f)) { const float alpha = __builtin_amdgcn_exp2f((mold - m) * SC2);
#pragma unroll 8
                for (int i = 0; i < 32; ++i) imprh[i * 32] *= alpha; }
            post(p0, p1, j);
            pv_tile(o, sb, va, p0, p1); } };
    tile_loop<2, false>(NT, lds, Kg, Vg, (const float*)nullptr, tid, wv, kf, djf, body);
    const float lt = half_sum(l);
    const float scl = lt > 0.f ? 1.0f / lt : 0.f;
    if ((tid & 63) < 32) sclw[tid & 31] = scl;
    const float inv = gate * scl;
#pragma unroll
    for (int d = 0; d < 4; ++d)
#pragma unroll
        for (int i = 0; i < 16; ++i) o[d][i] *= inv;
}
template <class XF>
__device__ __forceinline__ void nsa_branch_online(LAS unsigned char* lds, const bf16_t* Kg, const bf16_t* Vg, unsigned long long tiles, unsigned long long wact, int j0,
                                                  const bf16x8* qf, const bf16x8 qaug, const int* ka, int kaa, const int* va, int tid, int wv, float gate, f32x16* o, const XF& xf) {
    constexpr float SC2 = 0.08838834764831845f * LOG2E;
    LAS unsigned char* tl = lds + L_TL;
    if (tid == 0) { unsigned long long bits = tiles; int n = 0; while (bits) { tl[n++] = (unsigned char)ctz64(bits); bits &= bits - 1; } }
    const int NT = __builtin_popcountll(tiles);
    __syncthreads();
    float m = -1e30f, l = 0.f;
    auto kf = [&](int i) { return 64 * (int)tl[i]; };
    auto djf = [&](int i) { return (float)((int)tl[i] - j0); };
    auto body = [&](int t, LAS unsigned char* sb) { const int j = (int)__builtin_amdgcn_readfirstlane((int)tl[t]);
        if ((wact >> j) & 1ull) { f32x16 p0, p1; qk_tile<8, true>(p0, p1, sb, ka, kaa, qf, qaug); xf(p0, p1, j);
            softmax_step(p0, p1, m, l, o, SC2); pv_tile(o, sb, va, p0, p1); } };
    tile_loop<2, false>(NT, lds, Kg, Vg, (const float*)nullptr, tid, wv, kf, djf, body);
    const float inv = gate / half_sum(l);
#pragma unroll
    for (int d = 0; d < 4; ++d)
#pragma unroll
        for (int i = 0; i < 16; ++i) o[d][i] *= inv;
}
__device__ __forceinline__ void park_store(LAS unsigned* slab, int lane, const f32x16* o) {
#pragma unroll
    for (int d = 0; d < 4; ++d)
#pragma unroll
        for (int i = 0; i < 8; ++i) slab[(d * 8 + i) * 64 + lane] = cvt_pk_bf16(o[d][2 * i], o[d][2 * i + 1]);
}
__device__ __forceinline__ void park_add(const LAS unsigned* slab, int lane, f32x16* o) {
#pragma unroll
    for (int d = 0; d < 4; ++d)
#pragma unroll
        for (int i = 0; i < 8; ++i) { const unsigned w = slab[(d * 8 + i) * 64 + lane]; o[d][2 * i] += __uint_as_float(w << 16); o[d][2 * i + 1] += __uint_as_float(w & 0xffff0000u); }
}

__device__ __forceinline__ void nsa_item(int bg, int xq, LAS unsigned char* lds, const bf16_t* qkv, const bf16_t* kvc, const float* nsag, const unsigned* kbound, bf16_t* attb, const int wv) {
    const int tid = TID_OPAQUE(wv);
    const int wid = wv, lane = tid & 63, r32 = lane & 31, hi = lane >> 5, hw = (wid >> 1) ^ ((wid >> 2) & 1), sub = wid & 1;
    const int b = bg >> 1, g = bg & 1, hh = g * 4 + hw, q0 = xq * 64, qw = q0 + 32 * sub, qi = qw + r32, cur = xq;
    const bf16_t* Qg = qkv + ((size_t)((SL_NQ + hh) * 4 + b) * SEQ) * HD;
    bf16x8 qf[8]; load_q(qf, Qg + (size_t)qi * HD, hi);
    const size_t tok = (size_t)b * SEQ + qi;
    const float g0 = nsag[tok * 24 + hh * 3 + 0], g1 = nsag[tok * 24 + hh * 3 + 1], g2 = nsag[tok * 24 + hh * 3 + 2];
    const float a0 = exp2f(-(float)(hh + 1)) * 11.313708498984761f;
    const bf16x8 qaug = make_qaug(a0, 64.0f * a0, hi), qaugc = make_qaug(16.0f * a0, 1024.0f * a0, hi);
    int ka[8], va[4]; const int kaa = r32 * 16;
#pragma unroll
    for (int s = 0; s < 8; ++s) ka[s] = kaddr(lane, 2 * s + hi);
#pragma unroll
    for (int d = 0; d < 4; ++d) va[d] = vaddr(lane, d);
    f32x16 o[4];
#pragma unroll
    for (int d = 0; d < 4; ++d)
#pragma unroll
        for (int i = 0; i < 16; ++i) o[d][i] = 0.f;
    LAS float* impw = (LAS float*)(lds + L_NS) + wid * 2048;
    LAS unsigned* selm = (LAS unsigned*)(lds + L_SM);
    LAS unsigned* um = (LAS unsigned*)(lds + L_UM);
#pragma unroll
    for (int i = 0; i < 32; ++i) impw[i * 64 + lane] = 0.f;
    LAS int* t0m = (LAS int*)(lds + L_T0S);
    if (wid == 0) { selm[lane] = 0u; selm[64 + lane] = 0u; if (lane < 18) um[lane] = 0u; if (lane < 2) t0m[lane] = 64; }
    __syncthreads();
    int t0sel, t0win;
    { float qs = 0.f;
#pragma unroll
      for (int s = 0; s < 8; ++s)
#pragma unroll
          for (int e = 0; e < 8; ++e) { const float v = bf2f((bf16_t)qf[s][e]); qs = fmaf(v, v, qs); }
      qs = wave_max(half_sum(qs));
      const unsigned* kb = kbound + 1024 + (g * 4 + b) * 16;
      float kss = 0.f, ksw = 0.f;
#pragma unroll
      for (int pp = 0; pp < 16; ++pp) { kss += __uint_as_float(kb[pp]); ksw += __uint_as_float(kb[128 + pp]); }
      const float c2 = 2.0f * 1.02f * (0.08838834764831845f * LOG2E), isl = 1.0f / (exp2f(-(float)(hh + 1)) * LOG2E);
      const float vs = ((float)(qw - 63) - (36.0f + c2 * sqrtf(qs * kss)) * isl) * (1.0f / 64.0f), vw = ((float)(qw - 63) - (36.0f + c2 * sqrtf(qs * ksw)) * isl) * (1.0f / 64.0f);
      int ts = vs > 0.f ? (int)ceilf(vs) : 0, tw = vw > 0.f ? (int)ceilf(vw) : 0;
      ts = ts > cur ? cur : ts; tw = tw > cur ? cur : tw;
      t0sel = __builtin_amdgcn_readfirstlane(ts); t0win = __builtin_amdgcn_readfirstlane(tw);
      if (lane == 0) { __hip_atomic_fetch_min(t0m, t0sel, __ATOMIC_RELAXED, __HIP_MEMORY_SCOPE_WORKGROUP); __hip_atomic_fetch_min(t0m + 1, t0win, __ATOMIC_RELAXED, __HIP_MEMORY_SCOPE_WORKGROUP); } }
    {
        const int cq = qi >= 31 ? (qi - 31) >> 4 : -1;
        const int cmax_w = (qw + 31 - 31) >> 4;
        const int ntc = ((4 * xq + 2) >> 6) + 1;
        const unsigned long long tiles = (1ull << ntc) - 1ull;
        const unsigned long long wact = (1ull << ((cmax_w >> 6) + 1)) - 1ull;
        const int cqmin = qw >= 31 ? (qw - 31) >> 4 : -1;
        auto xf = [&](f32x16& p0, f32x16& p1, int j) {
            if (64 * j + 63 > cqmin) {
                asm volatile("; masked tile: keep this a real branch (rare path)");
                const int c0 = 64 * j + 4 * hi;
#pragma unroll
                for (int i = 0; i < 16; ++i) { const int c = c0 + (i & 3) + 8 * (i >> 2); p0[i] = c > cq ? NEG_INF : p0[i]; p1[i] = c + 32 > cq ? NEG_INF : p1[i]; } }
        };
        auto post = [&](const f32x16& p0, const f32x16& p1, int j) {
            LAS float* cell = impw + (16 * j + hi) * 32 + r32;
            const int paddr = (lane ^ 32) << 2;
            float X[4][2];
#pragma unroll
            for (int gq = 0; gq < 4; ++gq) { X[gq][0] = __int_as_float(__builtin_amdgcn_ds_bpermute(paddr, __float_as_int(p0[4 * gq + 3]))); X[gq][1] = __int_as_float(__builtin_amdgcn_ds_bpermute(paddr, __float_as_int(p1[4 * gq + 3]))); }
#pragma unroll
            for (int kh = 0; kh < 2; ++kh)
#pragma unroll
                for (int gq = 0; gq < 4; ++gq) {
                    const float sum4 = kh ? ((p1[4 * gq] + p1[4 * gq + 1]) + p1[4 * gq + 2]) + p1[4 * gq + 3] : ((p0[4 * gq] + p0[4 * gq + 1]) + p0[4 * gq + 2]) + p0[4 * gq + 3];
                    const float prevlo = gq ? X[gq - 1][kh] : (kh ? X[3][0] : 0.f);
                    cell[(8 * kh + 2 * gq) * 32] = sum4 + (hi ? X[gq][kh] : prevlo);
                }
            if (hi && 16 * j + 16 < 64) cell[15 * 32] += p1[15];
        };
        nsa_branch_cmp(lds, kvc + (size_t)(g * 4 + b) * 256 * HD, kvc + (size_t)(8 + g * 4 + b) * 256 * HD, tiles, wact, ntc - 1, qf, qaugc, ka, kaa, va, tid, wv, g0, o,
                       impw + 1024 * hi + r32, (LAS float*)(lds + L_SC) + wid * 32, xf, post);
    }
    __syncthreads();
    {
        const int q = tid >> 3, jg = tid & 7;
        const LAS float* ib = (const LAS float*)(lds + L_NS) + (q >> 5) * 2048 + jg * 256 + (q & 31);
        LAS float* v2 = (LAS float*)(lds + L_V2) + q * 64;
        const LAS float* scq = (const LAS float*)(lds + L_SC) + (q >> 5) * 32 + (q & 31);
        const float sc0 = scq[0], sc1 = scq[64], sc2 = scq[128], sc3 = scq[192];
        unsigned kj[8];
        LAS unsigned* v2u = (LAS unsigned*)v2;
#pragma unroll
        for (int e = 0; e < 8; ++e) { const int j = jg * 8 + e;
            const float imp = ((ib[32 * e] * sc0 + ib[4096 + 32 * e] * sc1) + ib[8192 + 32 * e] * sc2) + ib[12288 + 32 * e] * sc3;
            const bool vs = j <= cur, forced = (j == 0) || (j == cur) || (j == cur - 1);
            kj[e] = vs ? ((__float_as_uint(forced ? 1e4f : imp) & ~63u) | (unsigned)(63 - j)) : 0u; v2u[jg * 8 + e] = kj[e]; }
        __syncthreads();
        int rank[8];
#pragma unroll
        for (int e = 0; e < 8; ++e) rank[e] = 0;
        for (int i = 0; i < 64; ++i) { const unsigned ki = v2u[i];
#pragma unroll
            for (int e = 0; e < 8; ++e) rank[e] += ki > kj[e] ? 1 : 0; }
        unsigned bits = 0u;
#pragma unroll
        for (int e = 0; e < 8; ++e) bits |= (rank[e] < 16 && jg * 8 + e <= cur) ? (1u << e) : 0u;
        bits <<= 8 * (jg & 3);
        __hip_atomic_fetch_or(selm + q * 2 + (jg >> 2), bits, __ATOMIC_RELAXED, __HIP_MEMORY_SCOPE_WORKGROUP);
        __hip_atomic_fetch_or(um + (jg >> 2), bits, __ATOMIC_RELAXED, __HIP_MEMORY_SCOPE_WORKGROUP);
        __hip_atomic_fetch_or(um + 2 + 2 * ((q >> 5) + 0) + (jg >> 2), bits, __ATOMIC_RELAXED, __HIP_MEMORY_SCOPE_WORKGROUP);
        __syncthreads();
    }
    const unsigned sm0 = selm[2 * (qi - q0)], sm1 = selm[2 * (qi - q0) + 1];
    const unsigned long long mysel = ((unsigned long long)sm1 << 32) | sm0;
    const unsigned long long utiles = ((unsigned long long)(unsigned)__builtin_amdgcn_readfirstlane((int)um[1]) << 32) | (unsigned)__builtin_amdgcn_readfirstlane((int)um[0]);
    const unsigned long long wtiles = ((unsigned long long)(unsigned)__builtin_amdgcn_readfirstlane((int)um[2 + 2 * sub + 1]) << 32) | (unsigned)__builtin_amdgcn_readfirstlane((int)um[2 + 2 * sub]);
    __syncthreads();
    {
        auto xf = [&](f32x16& p0, f32x16& p1, int j) {
            const bool mine = (mysel >> j) & 1ull; const int dq = qi - 64 * j - 4 * hi;
            if (j == cur || !__all(mine)) {
                asm volatile("; masked tile: keep this a real branch (rare path)");
#pragma unroll
                for (int i = 0; i < 16; ++i) { const int c = (i & 3) + 8 * (i >> 2); p0[i] = (!mine || c > dq) ? NEG_INF : p0[i]; p1[i] = (!mine || c + 32 > dq) ? NEG_INF : p1[i]; } }
        };
        LAS unsigned* slab = (LAS unsigned*)(lds + L_NS) + wid * 2048;
        park_store(slab, lane, o);
#pragma unroll
        for (int d = 0; d < 4; ++d)
#pragma unroll
            for (int i = 0; i < 16; ++i) o[d][i] = 0.f;
        const int t0a = __builtin_amdgcn_readfirstlane(t0m[0]);
        nsa_branch_online(lds, qkv + ((size_t)((SL_NKS + g) * 4 + b) * SEQ) * HD, qkv + ((size_t)((SL_NVS + g) * 4 + b) * SEQ) * HD, utiles & (~0ull << t0a), wtiles & (~0ull << t0sel), cur, qf, qaug, ka, kaa, va, tid, wv, g1, o, xf);
        park_add(slab, lane, o); park_store(slab, lane, o);
#pragma unroll
        for (int d = 0; d < 4; ++d)
#pragma unroll
            for (int i = 0; i < 16; ++i) o[d][i] = 0.f;
    }
    {
        const int jlo = cur - 8 > 0 ? cur - 8 : 0;
        const unsigned long long tiles = (cur == 63 ? ~0ull : ((1ull << (cur + 1)) - 1ull)) & ~((1ull << jlo) - 1ull);
        auto xf = [&](f32x16& p0, f32x16& p1, int j) {
            const int dq = qi - 64 * j - 4 * hi;
            if (j == cur || j == cur - 8) {
                asm volatile("; masked tile: keep this a real branch (rare path)");
#pragma unroll
                for (int i = 0; i < 16; ++i) { const int c = (i & 3) + 8 * (i >> 2); p0[i] = (unsigned)(dq - c) >= 512u ? NEG_INF : p0[i]; p1[i] = (unsigned)(dq - c - 32) >= 512u ? NEG_INF : p1[i]; } }
        };
        const int t0a = __builtin_amdgcn_readfirstlane(t0m[1]);
        nsa_branch_online(lds, qkv + ((size_t)((SL_NKW + g) * 4 + b) * SEQ) * HD, qkv + ((size_t)((SL_NVW + g) * 4 + b) * SEQ) * HD, tiles & (~0ull << t0a), tiles & (~0ull << t0win), cur, qf, qaug, ka, kaa, va, tid, wv, g2, o, xf);
        park_add((const LAS unsigned*)(lds + L_NS) + wid * 2048, lane, o);
    }
    bf16_t* orow = attb + tok * DM + 1024 + hh * HD;
#pragma unroll
    for (int d = 0; d < 4; ++d)
#pragma unroll
        for (int gq = 0; gq < 4; ++gq) { u32x2 w; w.x = cvt_pk_bf16(o[d][4 * gq], o[d][4 * gq + 1]); w.y = cvt_pk_bf16(o[d][4 * gq + 2], o[d][4 * gq + 3]);
            *(u32x2*)(orow + 32 * d + 8 * gq + 4 * hi) = w; }
}
}

#define XB_TMO      128
#define XB_XCNT(j)  (256  + 64 * (j))
#define XB_XSUB(j)  (1280 + 64 * (j))
#define XB_XGEN(j)  (2304 + 64 * (j))
#define XB_TOP      3328
#define XB_TOPGEN   3392
#define XCD_BAR_WORDS 3456
#define XB_SPIN_CAP (1u << 22)

__device__ __forceinline__ unsigned xb_ld(unsigned* p)              { return __hip_atomic_load(p, __ATOMIC_RELAXED, __HIP_MEMORY_SCOPE_AGENT); }
__device__ __forceinline__ unsigned xb_add(unsigned* p, unsigned v) { return __hip_atomic_fetch_add(p, v, __ATOMIC_RELAXED, __HIP_MEMORY_SCOPE_AGENT); }
__device__ __forceinline__ unsigned xb_xcc_id() { return (unsigned)__builtin_amdgcn_s_getreg((3 << 11) | 20) & 0xFu; }
#define XB_SPIN(cond, bar) do { unsigned _sp = 0; while (cond) { __builtin_amdgcn_s_sleep(1); \
    if ((++_sp & 255u) == 0u) { if (xb_ld(&(bar)[XB_TMO])) break; if (_sp > XB_SPIN_CAP) { atomicAdd(&(bar)[XB_TMO], 1u); break; } } } } while (0)

struct XcdBarrier { unsigned* bar; volatile LAS unsigned* st; };

__device__ __forceinline__ XcdBarrier xcd_barrier_post(unsigned* bar, volatile LAS unsigned* st, const int wv) {
    XcdBarrier b; b.bar = bar; b.st = st;
    if (TID_OPAQUE(wv) == 0) { const unsigned x = xb_xcc_id(); st[2] = x; (void)xb_add(&bar[XB_XCNT(x)], 1u); }
    return b;
}
__device__ __forceinline__ void xcd_barrier_complete(unsigned* bar, unsigned x, unsigned& nloc, unsigned& nx) {
    const unsigned G = gridDim.x * gridDim.y * gridDim.z;
    unsigned sum, cnt, mine, sp = 0u;
    for (;;) {
        sum = 0u; cnt = 0u; mine = 0u;
#pragma unroll
        for (unsigned j = 0; j < 16; ++j) { const unsigned c = xb_ld(&bar[XB_XCNT(j)]); sum += c; cnt += (c > 0u) ? 1u : 0u; mine = (j == x) ? c : mine; }
        if (sum == G) break;
        __builtin_amdgcn_s_sleep(1);
        if ((++sp & 255u) == 0u) { if (xb_ld(&bar[XB_TMO])) break; if (sp > XB_SPIN_CAP) { atomicAdd(&bar[XB_TMO], 1u); break; } }
    }
    nloc = mine > 0u ? mine : 1u; nx = cnt > 0u ? cnt : 1u;
}
__device__ __forceinline__ void xcd_barrier(const XcdBarrier& b, const int wv) {
    asm volatile("s_waitcnt vmcnt(0)" ::: "memory");
    __syncthreads();
    if (TID_OPAQUE(wv) == 0) {
        unsigned* bar = b.bar;
        __builtin_amdgcn_s_waitcnt(0);
        unsigned nloc = b.st[0], nx = b.st[1]; const unsigned bx = b.st[2];
        if (nloc == 0u) { xcd_barrier_complete(bar, bx, nloc, nx); b.st[0] = nloc; b.st[1] = nx; }
        const unsigned old = xb_add(&bar[XB_XSUB(bx)], 1u);
        const unsigned gen = old / nloc;
        if (old + 1u == (gen + 1u) * nloc) {
            __builtin_amdgcn_fence(__ATOMIC_RELEASE, "agent");
            asm volatile("s_waitcnt vmcnt(0)" ::: "memory");
            const unsigned og = xb_add(&bar[XB_TOP], 1u);
            const unsigned tg = og / nx;
            if (og + 1u == (tg + 1u) * nx) xb_add(&bar[XB_TOPGEN], 1u);
            else XB_SPIN(xb_ld(&bar[XB_TOPGEN]) == tg, bar);
            __builtin_amdgcn_fence(__ATOMIC_ACQUIRE, "agent");
            xb_add(&bar[XB_XGEN(bx)], 1u);
            asm volatile("s_waitcnt vmcnt(0)" ::: "memory");
        } else {
            XB_SPIN(xb_ld(&bar[XB_XGEN(bx)]) == gen, bar);
            __builtin_amdgcn_fence(__ATOMIC_ACQUIRE, "agent");
            asm volatile("s_waitcnt vmcnt(0)" ::: "memory");
        }
    }
    __syncthreads();
}

struct Params {
    const float* x_in; const float* w_in; const float* fbias; const float* dlam; const float* subln; const float* cpos; const float* cw1; const float* cw2;
    const float* wbf; const float* wbd; const float* wbn; const float* wgate; const float* wout; const float* gains; const float* wup; const float* wdn;
    float* xo; unsigned char* ws;
};
constexpr int LDS_GEMM = pg8::STAGE_BYTES;
constexpr int LDS_BARW = att::L_BARW;
constexpr int LDS_TOTAL = att::LDS_ATT_TOTAL;
static_assert(att::NSA_END <= att::L_T0S && att::L_X3 + 1024 <= att::L_T0S && LDS_GEMM <= att::L_T0S && att::L_DX + 65536 <= att::L_T0S, "LDS map");

typedef const __attribute__((address_space(4))) Params* KParams;
struct CvtJob { const float* src; bf16_t* dst; const float* gain; int K, Nsrc, ldd, nrows, mode, pad; };
__device__ __forceinline__ CvtJob cvt_job(KParams p, int l, int j) {
    bf16_t* W = (bf16_t*)(p->ws + WS_W) + (size_t)l * LW_EL; CvtJob J{};
    switch (j) {
        case 0: J.src = p->w_in + (size_t)l * DM * IN_COLS; J.dst = W + OFF_W1T; J.K = DM; J.Nsrc = IN_COLS; J.ldd = DM; J.nrows = 5888; J.mode = 1; J.gain = p->gains + (size_t)(l * 4 + 0) * DM; break;
        case 1: J.src = p->wgate + (size_t)l * DM * 6144; J.dst = W + OFF_W1T + (size_t)5888 * DM; J.K = DM; J.Nsrc = 6144; J.ldd = DM; J.nrows = 6144; J.mode = 0; J.gain = p->gains + (size_t)(l * 4 + 0) * DM; break;
        case 2: J.src = p->wbf + (size_t)l * 512 * DM; J.dst = W + OFF_WBT; J.K = 512; J.Nsrc = DM; J.ldd = DM; J.nrows = DM; J.mode = 0; break;
        case 3: J.src = p->wbd + (size_t)l * 512 * DM; J.dst = W + OFF_WBT + 512; J.K = 512; J.Nsrc = DM; J.ldd = DM; J.nrows = DM; J.mode = 0; break;
        case 4: J.src = p->wbn + (size_t)l * 1024 * DM; J.dst = W + OFF_WBT + 1024; J.K = 1024; J.Nsrc = DM; J.ldd = DM; J.nrows = DM; J.mode = 0; break;
        case 5: J.src = p->wout + (size_t)l * DM * DM; J.dst = W + OFF_WOT; J.K = DM; J.Nsrc = DM; J.ldd = DM; J.nrows = DM; J.mode = 0; break;
        case 6: J.src = p->wup + (size_t)l * DM * 2 * DFF; J.dst = W + OFF_WUP; J.K = DM; J.Nsrc = 2 * DFF; J.ldd = DM; J.nrows = 2 * DFF; J.mode = 2; J.gain = p->gains + (size_t)(l * 4 + 2) * DM; break;
        case 7: J.src = p->wdn + (size_t)l * DFF * DM; J.dst = W + OFF_WDN; J.K = DFF; J.Nsrc = DM; J.ldd = DFF; J.nrows = DM; J.mode = 0; break;
        case 8: J.src = p->cw1 + ((size_t)l * 2 + 0) * 4096 * 256; J.dst = W + OFF_WC1; J.K = 4096; J.Nsrc = 256; J.ldd = 4096; J.nrows = 256; J.mode = 0; break;
        case 10: J.src = p->cw2 + ((size_t)l * 2 + 0) * 256 * 128; J.dst = W + OFF_WC2; J.K = 256; J.Nsrc = 128; J.ldd = 256; J.nrows = 128; J.mode = 0; break;
        case 11: J.src = p->cw2 + ((size_t)l * 2 + 1) * 256 * 128; J.dst = W + OFF_WC2 + (size_t)128 * 256; J.K = 256; J.Nsrc = 128; J.ldd = 256; J.nrows = 128; J.mode = 0; break;
        default: J.src = p->cw1 + ((size_t)l * 2 + 1) * 4096 * 256; J.dst = W + OFF_WC1 + (size_t)256 * 4096; J.K = 4096; J.Nsrc = 256; J.ldd = 4096; J.nrows = 256; J.mode = 0; break;
    }
    return J;
}
__device__ __forceinline__ void cvt_tile(const CvtJob& J, int tile, const int wv) {
    const int t = TID_OPAQUE(wv), kb = t & 7, n4 = t >> 3;
    const int nbn = (J.nrows + 255) >> 8, n0 = (tile % nbn) * 256 + 4 * n4, k0 = (tile / nbn) * 64 + 8 * kb;
    if (n0 >= J.nrows) return;
    const int sc = colmap(J.mode, n0);
    f32x4 v[8];
#pragma unroll
    for (int jj = 0; jj < 8; ++jj) v[jj] = sc >= 0 ? *(const f32x4*)(J.src + (size_t)(k0 + jj) * J.Nsrc + sc) : (f32x4){0.f, 0.f, 0.f, 0.f};
    if (J.gain) { const f32x4 ga = *(const f32x4*)(J.gain + k0), gb = *(const f32x4*)(J.gain + k0 + 4);
#pragma unroll
        for (int jj = 0; jj < 4; ++jj) { v[jj] *= ga[jj]; v[4 + jj] *= gb[jj]; } }
#pragma unroll
    for (int e = 0; e < 4; ++e) { u32x4 w; w.x = cvt_pk_bf16(v[0][e], v[1][e]); w.y = cvt_pk_bf16(v[2][e], v[3][e]); w.z = cvt_pk_bf16(v[4][e], v[5][e]); w.w = cvt_pk_bf16(v[6][e], v[7][e]);
        *(u32x4*)(J.dst + (size_t)(n0 + e) * J.ldd + k0) = w; }
}
__device__ __forceinline__ void posb_item(const float* cpos, const float* cw1, unsigned char* wsb, int item, float* red, const int wv) {
    const int tid_o = TID_OPAQUE(wv);
    const int lj = item >> 3, hb = item & 7, t = tid_o, hid = hb * 32 + (t & 31), sl = t >> 5;
    const float* pp = cpos + (size_t)lj * 4096 + sl * 256; const float* w = cw1 + (size_t)lj * 4096 * 256 + (size_t)sl * 256 * 256 + hid;
    float s = 0.f;
#pragma unroll 8
    for (int kk = 0; kk < 256; ++kk) s = fmaf(pp[kk], w[(size_t)kk * 256], s);
    __syncthreads();
    red[sl * 32 + (t & 31)] = s;
    __syncthreads();
    if (t < 32) { float a = 0.f;
#pragma unroll
        for (int i = 0; i < 16; ++i) a += red[i * 32 + t];
        ((float*)(wsb + WS_POSB))[lj * 256 + hb * 32 + t] = a; }
}
__device__ __forceinline__ void rms_first_row(const float* x, bf16_t* xb, float* rstd, int row, int lane) {
    const f32x4* xr = (const f32x4*)(x + (size_t)row * DM) + lane;
    f32x4 v[8]; float s = 0.f;
#pragma unroll
    for (int j = 0; j < 8; ++j) { v[j] = xr[64 * j]; s += (v[j][0] * v[j][0] + v[j][1] * v[j][1]) + (v[j][2] * v[j][2] + v[j][3] * v[j][3]); }
    const float rs = rsqrtf(wave_sum(s) * (1.f / DM) + EPS);
    if (lane == 0) rstd[row] = rs;
    u32x2* o = (u32x2*)(xb + (size_t)row * DM) + lane;
#pragma unroll
    for (int j = 0; j < 8; ++j) { u32x2 w; w.x = cvt_pk_bf16(v[j][0] * rs, v[j][1] * rs); w.y = cvt_pk_bf16(v[j][2] * rs, v[j][3] * rs); o[64 * j] = w; }
}
__device__ __forceinline__ void rms_post_row(const float* xf32, const bf16_t* y, const float* ga, bf16_t* xb, float* rstd, float* xout, int row, int lane) {
    const u32x2* yr = (const u32x2*)(y + (size_t)row * DM) + lane; const f32x4* gar = (const f32x4*)ga + lane;
    u32x2* xbr = (u32x2*)(xb + (size_t)row * DM) + lane;
    f32x4 v[8], xv[8]; u32x2 yy[8]; float s = 0.f;
#pragma unroll
    for (int j = 0; j < 8; ++j) yy[j] = yr[64 * j];
    if (xf32) {
#pragma unroll
        for (int j = 0; j < 8; ++j) xv[j] = ((const f32x4*)(xf32 + (size_t)row * DM) + lane)[64 * j];
    } else { const float ir = 1.0f / rstd[row];
#pragma unroll
        for (int j = 0; j < 8; ++j) { const u32x2 xx = xbr[64 * j]; xv[j] = (f32x4){__uint_as_float(xx.x << 16) * ir, __uint_as_float(xx.x & 0xffff0000u) * ir, __uint_as_float(xx.y << 16) * ir, __uint_as_float(xx.y & 0xffff0000u) * ir}; }
    }
#pragma unroll
    for (int j = 0; j < 8; ++j) { v[j] = (f32x4){__uint_as_float(yy[j].x << 16), __uint_as_float(yy[j].x & 0xffff0000u), __uint_as_float(yy[j].y << 16), __uint_as_float(yy[j].y & 0xffff0000u)}; s += (v[j][0] * v[j][0] + v[j][1] * v[j][1]) + (v[j][2] * v[j][2] + v[j][3] * v[j][3]); }
    const float rsy = rsqrtf(wave_sum(s) * (1.f / DM) + EPS);
    float s2 = 0.f;
#pragma unroll
    for (int j = 0; j < 8; ++j) { const f32x4 gg = gar[64 * j];
#pragma unroll
        for (int i = 0; i < 4; ++i) v[j][i] = xv[j][i] + v[j][i] * rsy * gg[i];
        s2 += (v[j][0] * v[j][0] + v[j][1] * v[j][1]) + (v[j][2] * v[j][2] + v[j][3] * v[j][3]); }
    if (xout) { f32x4* xo = (f32x4*)(xout + (size_t)row * DM) + lane;
#pragma unroll
        for (int j = 0; j < 8; ++j) xo[64 * j] = v[j]; }
    else { const float rsx = rsqrtf(wave_sum(s2) * (1.f / DM) + EPS); if (lane == 0) rstd[row] = rsx;
#pragma unroll
        for (int j = 0; j < 8; ++j) { u32x2 n; n.x = cvt_pk_bf16(v[j][0] * rsx, v[j][1] * rsx); n.y = cvt_pk_bf16(v[j][2] * rsx, v[j][3] * rsx); xbr[64 * j] = n; } }
}
__device__ __forceinline__ void cumsum_item(int bh, const float* logf, float* cum, float* part, const int wv) {
    const int tid_o = TID_OPAQUE(wv);
    const int b = bh >> 2, h = bh & 3, t = tid_o;
    float v[8]; float s = 0.f;
#pragma unroll
    for (int i = 0; i < 8; ++i) { s += logf[((size_t)b * SEQ + t * 8 + i) * 4 + h]; v[i] = s; }
    __syncthreads();
    part[t] = s; __syncthreads();
    for (int o = 1; o < 512; o <<= 1) { float a = t >= o ? part[t - o] : 0.f; __syncthreads(); part[t] += a; __syncthreads(); }
    const float base = t ? part[t - 1] : 0.f;
#pragma unroll
    for (int i = 0; i < 8; ++i) cum[(size_t)bh * SEQ + t * 8 + i] = base + v[i];
}
__device__ __forceinline__ void cmp2_item(int item, const bf16_t* h1, const float* w2, bf16_t* kvc, const int wv) {
    const int tid_o = TID_OPAQUE(wv);
    const int row = item * 4 + (tid_o >> 7), n = tid_o & 127, panel = row >> 8, j = panel >> 3;
    const bf16_t* hr = h1 + (size_t)row * 256; const float* w = w2 + (size_t)j * 256 * 128 + n;
    float s = 0.f;
#pragma unroll 8
    for (int k = 0; k < 256; ++k) s = fmaf(bf2f(hr[k]), w[(size_t)k * 128], s);
    kvc[(size_t)row * 128 + n] = f2bf(s);
}
__device__ __forceinline__ void cmp2_panel(int panel, const bf16_t* h1, const bf16_t* w2t, bf16_t* kvc, const int wv) {
    const int lane = lane_id_opaque(), r32 = lane & 31, hi = lane >> 5, row = panel * 256 + 32 * wv + r32, j = panel >> 3;
    const bf16_t* hr = h1 + (size_t)row * 256 + 8 * hi;
    bf16x8 a[16];
#pragma unroll
    for (int s = 0; s < 16; ++s) a[s] = *(const bf16x8*)(hr + 16 * s);
#pragma unroll
    for (int nb = 0; nb < 4; ++nb) {
        f32x16 acc;
#pragma unroll
        for (int i = 0; i < 16; ++i) acc[i] = 0.f;
        const bf16_t* wr = w2t + ((size_t)j * 128 + 32 * nb + r32) * 256 + 8 * hi;
#pragma unroll
        for (int s = 0; s < 16; ++s) { const bf16x8 bw = *(const bf16x8*)(wr + 16 * s); acc = __builtin_amdgcn_mfma_f32_32x32x16_bf16(bw, a[s], acc, 0, 0, 0); }
#pragma unroll
        for (int gq = 0; gq < 4; ++gq) { u32x2 w; w.x = cvt_pk_bf16(acc[4 * gq], acc[4 * gq + 1]); w.y = cvt_pk_bf16(acc[4 * gq + 2], acc[4 * gq + 3]);
            *(u32x2*)(kvc + (size_t)row * 128 + 32 * nb + 8 * gq + 4 * hi) = w; }
        __builtin_amdgcn_sched_barrier(0);
    }
}
struct CmpOrder2 {
    int c;
    __device__ bool next(int i, pg8::Unit& u) const { if (i > 0 || c < 0 || c >= 16) return false; u.pm = c; u.pn = c >> 3; return true; }
};

__device__ __forceinline__ KParams opq_kp() { KParams k = (KParams)__builtin_amdgcn_kernarg_segment_ptr(); asm volatile("" : "+s"(k)); return k; }
#define GAS __attribute__((address_space(1)))
template <class Tp> __device__ __forceinline__ Tp* as_global(Tp* p) { return (Tp*)(GAS Tp*)p; }
#define PRM(f) (as_global(opq_kp()->f))
constexpr int CVT_NJ = 12;
constexpr int cvt_ntile(int j) { return j == 0 ? 23 * 32 : j == 1 ? 24 * 32 : j == 2 ? 8 * 8 : j == 3 ? 8 * 8 : j == 4 ? 8 * 16 : j == 5 ? 8 * 32 : j == 6 ? 44 * 32 : j == 7 ? 8 * 88 : j == 8 ? 64 : j == 9 ? 64 : 4; }
constexpr int cvt_pre(int j) { int s = 0; for (int i = 0; i < j; ++i) s += cvt_ntile(i); return s; }
constexpr int CVT_TILES = cvt_pre(CVT_NJ);
__device__ __forceinline__ void cvt_global_tile(int l, int gt, const int wv) {
    int j = 0;
#pragma unroll
    for (int i = 1; i < CVT_NJ; ++i) j += (gt >= cvt_pre(i)) ? 1 : 0;
    int pre = 0;
#pragma unroll
    for (int i = 1; i < CVT_NJ; ++i) pre = (gt >= cvt_pre(i)) ? cvt_pre(i) : pre;
    const CvtJob J = cvt_job(opq_kp(), l, j);
    cvt_tile(J, gt - pre, wv);
}
__device__ __forceinline__ void flag_wait(unsigned* flag, unsigned* bar, const int wv) {
    __syncthreads();
    if (TID_OPAQUE(wv) == 0) { XB_SPIN(xb_ld(flag) < 16u, bar); __builtin_amdgcn_fence(__ATOMIC_ACQUIRE, "agent"); asm volatile("s_waitcnt vmcnt(0)" ::: "memory"); }
    __syncthreads();
}
#define OPQ_WS() ({ GAS unsigned char* w_ = (GAS unsigned char*)(opq_kp()->ws); asm volatile("" : "+s"(w_)); w_; })
#define WSP(ty, off) ((ty*)(ws + (off)))
__global__ __launch_bounds__(512, 2) void k_mega(Params p_unused) {
    extern __shared__ __attribute__((aligned(16))) unsigned char shm[];
    LAS unsigned char* lds = (LAS unsigned char*)shm;
    const int wv = __builtin_amdgcn_readfirstlane((int)threadIdx.x >> 6), G = (int)gridDim.x, bid = (int)blockIdx.x;
    if (TID_OPAQUE(wv) == 0) *(uint4*)(shm + LDS_BARW) = make_uint4(0u, 0u, 0u, 0u);
    __syncthreads();
    XcdBarrier bar = xcd_barrier_post((unsigned*)(PRM(ws) + WS_CTL), (volatile LAS unsigned*)(lds + LDS_BARW), wv);

    for (int gt = bid; gt < CVT_TILES; gt += G) cvt_global_tile(0, gt, wv);
    for (int it = bid; it < NLAYER * 2 * 8; it += G) posb_item(PRM(cpos), PRM(cw1), PRM(ws), it, (float*)shm, wv);
    { GAS unsigned char* ws = OPQ_WS(); const int t_ = TID_OPAQUE(wv); for (int row = bid * 8 + (t_ >> 6); row < T; row += G * 8) rms_first_row(PRM(x_in), WSP(bf16_t, WS_HB), WSP(float, WS_RSTD), row, t_ & 63); }
    xcd_barrier(bar, wv);

    for (int l = 0; l < NLAYER; ++l) {
        const float lam_init = __int_as_float(__builtin_amdgcn_readfirstlane(__float_as_int(l == 0 ? 0.2f : (l == 1 ? 0.35550906759096934f : (l == 2 ? 0.4707130183435842f : 0.5560582041556406f)))));
        const float oml = __int_as_float(__builtin_amdgcn_readfirstlane(__float_as_int(l == 0 ? 0.8f : (l == 1 ? 0.64449093240903066f : (l == 2 ? 0.5292869816564158f : 0.4439417958443594f)))));
        { GAS unsigned char* ws = OPQ_WS(); const bf16_t* W = WSP(bf16_t, WS_W) + (size_t)l * LW_EL;
          pg8::Gemm g{}; g.A = WSP(bf16_t, WS_HB); g.Bt = W + OFF_W1T; g.M = T; g.N = N1; g.K = DM; g.lda = DM; g.ldb = DM;
          pg8::Epi1 e{}; e.qkv = WSP(bf16_t, WS_QKV); e.logf = WSP(float, WS_LOGF); e.nsag = WSP(float, WS_NSAG); e.gates = WSP(bf16_t, WS_GATES); e.fbias = PRM(fbias) + l * 4; e.rstd = WSP(float, WS_RSTD); e.kbound = (unsigned*)(ws + WS_CTL + CTL_KB) + l * 256;
          int bq = bid; asm volatile("" : "+s"(bq)); pg8::StaticOrder S; S.init(g.M, g.N, G, bq);
          pg8::gemm_phase<pg8::Epi1, pg8::StaticOrder>(lds, g, S, e, wv); }
        if (l + 1 < NLAYER && bid >= (64 * 47) % G) { GAS unsigned char* ws = OPQ_WS(); unsigned* ctr = (unsigned*)(ws + WS_CTL + 16384) + 64 * ((l * 4 + 3) * 8); LAS int* slot = (LAS int*)(lds + att::L_SLOT);
          const int it = att::queue_next(ctr, slot, wv);
          if (it * 8 < CVT_TILES) {
#pragma unroll 1
              for (int u = 0; u < 8; ++u) { const int gt = it * 8 + u; if (gt < CVT_TILES) cvt_global_tile(l + 1, gt, wv); } }
          __syncthreads(); }
        xcd_barrier(bar, wv);
        { GAS unsigned char* ws = OPQ_WS(); const bf16_t* W = WSP(bf16_t, WS_W) + (size_t)l * LW_EL;
          int bq = bid; asm volatile("" : "+s"(bq));
          pg8::Gemm g{}; g.A = WSP(bf16_t, WS_QKV) + (size_t)SL_NKC * 4 * SEQ * HD; g.Bt = W + OFF_WC1; g.M = 4096; g.N = 512; g.K = 4096; g.lda = 2048; g.ldb = 4096;
          pg8::EpiC1 e{}; e.h1 = WSP(bf16_t, WS_H1); e.posb = WSP(float, WS_POSB) + l * 512;
          CmpOrder2 S; S.c = bq;
          pg8::gemm_phase<pg8::EpiC1, CmpOrder2>(lds, g, S, e, wv);
          if (bq < 16) { asm volatile("s_waitcnt vmcnt(0)" ::: "memory"); __syncthreads();
              cmp2_panel(bq, WSP(bf16_t, WS_H1), W + OFF_WC2, WSP(bf16_t, WS_KVC), wv); }
          else if (bq < 32) cumsum_item(bq - 16, WSP(float, WS_LOGF), WSP(float, WS_CUM), (float*)shm, wv);
          if (bq < 32) {
              asm volatile("s_waitcnt vmcnt(0)" ::: "memory"); __syncthreads();
              if (TID_OPAQUE(wv) == 0) { __builtin_amdgcn_fence(__ATOMIC_RELEASE, "agent"); xb_add((unsigned*)(ws + WS_CTL + 49152) + 64 * (l * 2 + (bq >> 4)), 1u); } } }
        { GAS unsigned char* ws = OPQ_WS(); LAS int* slot = (LAS int*)(lds + att::L_SLOT); const int myx = (int)(xb_xcc_id() & 7u);
          for (int dx = 0; dx < 8; ++dx) { const int x = (myx + dx) & 7; unsigned* ctr = (unsigned*)(ws + WS_CTL + 16384) + 64 * ((l * 4 + 1) * 8 + x);
            for (;;) { const int it = att::queue_next(ctr, slot, wv); if (it >= 32) break;
              att::diff_item((x >> 1) * 4 + 2 + (x & 1), 31 - it, lds, WSP(bf16_t, WS_QKV), (const unsigned*)(ws + WS_CTL + CTL_KB) + l * 256, PRM(dlam) + l * 256, PRM(subln) + l * 128, lam_init, oml, WSP(bf16_t, WS_ATT), wv); } }
          __syncthreads(); }
        { GAS unsigned char* ws = OPQ_WS(); LAS int* slot = (LAS int*)(lds + att::L_SLOT); const int myx = (int)(xb_xcc_id() & 7u);
          flag_wait((unsigned*)(ws + WS_CTL + 49152) + 64 * (l * 2 + 1), (unsigned*)(ws + WS_CTL), wv);
          for (int dx = 0; dx < 8; ++dx) { const int x = (myx + dx) & 7; unsigned* ctr = (unsigned*)(ws + WS_CTL + 16384) + 64 * ((l * 4 + 0) * 8 + x);
            for (;;) { const int it = att::queue_next(ctr, slot, wv); if (it >= 32) break;
              att::fox_item(2 * x + (it & 1), 15 - (it >> 1), lds, WSP(bf16_t, WS_QKV), WSP(float, WS_CUM), (const unsigned*)(ws + WS_CTL + CTL_KB) + l * 256, WSP(bf16_t, WS_ATT), wv); } }
          __syncthreads(); }
        { GAS unsigned char* ws = OPQ_WS(); LAS int* slot = (LAS int*)(lds + att::L_SLOT); const int myx = (int)(xb_xcc_id() & 7u);
          flag_wait((unsigned*)(ws + WS_CTL + 49152) + 64 * (l * 2 + 0), (unsigned*)(ws + WS_CTL), wv);
          for (int dx = 0; dx < 8; ++dx) { const int x = (myx + dx) & 7; unsigned* ctr = (unsigned*)(ws + WS_CTL + 16384) + 64 * ((l * 4 + 2) * 8 + x);
            for (;;) { const int it = att::queue_next(ctr, slot, wv); if (it >= 64) break;
              att::nsa_item(x, 63 - it, lds, WSP(bf16_t, WS_QKV), WSP(bf16_t, WS_KVC), WSP(float, WS_NSAG), (const unsigned*)(ws + WS_CTL + CTL_KB) + l * 256, WSP(bf16_t, WS_ATT), wv); } }
          __syncthreads(); }
        { GAS unsigned char* ws = OPQ_WS(); LAS int* slot = (LAS int*)(lds + att::L_SLOT); const int myx = (int)(xb_xcc_id() & 7u);
          for (int dx = 0; dx < 8; ++dx) { const int x = (myx + dx) & 7; unsigned* ctr = (unsigned*)(ws + WS_CTL + 53248) + 64 * (l * 8 + x);
            for (;;) { const int it = att::queue_next(ctr, slot, wv); if (it >= 32) break;
              att::diff_item((x >> 1) * 4 + (x & 1), 31 - it, lds, WSP(bf16_t, WS_QKV), (const unsigned*)(ws + WS_CTL + CTL_KB) + l * 256, PRM(dlam) + l * 256, PRM(subln) + l * 128, lam_init, oml, WSP(bf16_t, WS_ATT), wv); } }
          __syncthreads(); }
        if (l + 1 < NLAYER) { GAS unsigned char* ws = OPQ_WS(); unsigned* ctr = (unsigned*)(ws + WS_CTL + 16384) + 64 * ((l * 4 + 3) * 8); LAS int* slot = (LAS int*)(lds + att::L_SLOT);
          for (;;) { const int it = att::queue_next(ctr, slot, wv); if (it * 8 >= CVT_TILES) break;
#pragma unroll 1
              for (int u = 0; u < 8; ++u) { const int gt = it * 8 + u; if (gt < CVT_TILES) cvt_global_tile(l + 1, gt, wv); } }
          __syncthreads(); }
        xcd_barrier(bar, wv);
        { GAS unsigned char* ws = OPQ_WS(); const bf16_t* W = WSP(bf16_t, WS_W) + (size_t)l * LW_EL;
          pg8::Gemm g{}; g.A = WSP(bf16_t, WS_ATT); g.Bt = W + OFF_WBT; g.M = T; g.N = DM; g.K = DM; g.lda = DM; g.ldb = DM;
          pg8::Epi2 e{}; e.gates = WSP(bf16_t, WS_GATES); e.out = WSP(bf16_t, WS_MRG);
          int bq = bid; asm volatile("" : "+s"(bq)); pg8::StaticOrder S; S.init(g.M, g.N, G, bq);
          pg8::gemm_phase<pg8::Epi2, pg8::StaticOrder>(lds, g, S, e, wv); }
        xcd_barrier(bar, wv);
        { GAS unsigned char* ws = OPQ_WS(); const bf16_t* W = WSP(bf16_t, WS_W) + (size_t)l * LW_EL;
          pg8::Gemm g{}; g.A = WSP(bf16_t, WS_MRG); g.Bt = W + OFF_WOT; g.M = T; g.N = DM; g.K = DM; g.lda = DM; g.ldb = DM;
          pg8::EpiBf16P e{}; e.C = WSP(bf16_t, WS_Y); e.ldc = DM;
          int bq = bid; asm volatile("" : "+s"(bq)); pg8::StaticOrder S; S.init(g.M, g.N, G, bq);
          pg8::gemm_phase<pg8::EpiBf16P, pg8::StaticOrder>(lds, g, S, e, wv); }
        xcd_barrier(bar, wv);
        { GAS unsigned char* ws = OPQ_WS(); const float* gl = PRM(gains) + (size_t)l * 4 * DM; const int t_ = TID_OPAQUE(wv);
          for (int row = bid * 8 + (t_ >> 6); row < T; row += G * 8) rms_post_row(l == 0 ? PRM(x_in) : (const float*)nullptr, WSP(bf16_t, WS_Y), gl + DM, WSP(bf16_t, WS_HB), WSP(float, WS_RSTD), (float*)nullptr, row, t_ & 63); }
        xcd_barrier(bar, wv);
        { GAS unsigned char* ws = OPQ_WS(); const bf16_t* W = WSP(bf16_t, WS_W) + (size_t)l * LW_EL;
          pg8::Gemm g{}; g.A = WSP(bf16_t, WS_HB); g.Bt = W + OFF_WUP; g.M = T; g.N = 2 * DFF; g.K = DM; g.lda = DM; g.ldb = DM;
          pg8::EpiSwiGLU e{}; e.hid = WSP(bf16_t, WS_HID); e.rstd = WSP(float, WS_RSTD);
          int bq = bid; asm volatile("" : "+s"(bq)); pg8::StaticOrder S; S.init(g.M, g.N, G, bq);
          pg8::gemm_phase<pg8::EpiSwiGLU, pg8::StaticOrder>(lds, g, S, e, wv); }
        xcd_barrier(bar, wv);
        { GAS unsigned char* ws = OPQ_WS(); const bf16_t* W = WSP(bf16_t, WS_W) + (size_t)l * LW_EL;
          pg8::Gemm g{}; g.A = WSP(bf16_t, WS_HID); g.Bt = W + OFF_WDN; g.M = T; g.N = DM; g.K = DFF; g.lda = DFF; g.ldb = DFF;
          pg8::EpiBf16P e{}; e.C = WSP(bf16_t, WS_Y); e.ldc = DM;
          int bq = bid; asm volatile("" : "+s"(bq)); pg8::StaticOrder S; S.init(g.M, g.N, G, bq);
          pg8::gemm_phase<pg8::EpiBf16P, pg8::StaticOrder>(lds, g, S, e, wv); }
        xcd_barrier(bar, wv);
        { GAS unsigned char* ws = OPQ_WS(); const float* gl = PRM(gains) + (size_t)l * 4 * DM; const int t_ = TID_OPAQUE(wv);
          for (int row = bid * 8 + (t_ >> 6); row < T; row += G * 8) rms_post_row((const float*)nullptr, WSP(bf16_t, WS_Y), gl + 3 * DM, WSP(bf16_t, WS_HB), WSP(float, WS_RSTD), l + 1 < NLAYER ? (float*)nullptr : PRM(xo), row, t_ & 63); }
        if (l + 1 < NLAYER) xcd_barrier(bar, wv);
    }
}

extern "C" void kernel_launch(void* const* d_in, const int* in_sizes, int n_in, void* d_out, int out_size, void* d_ws, size_t ws_size, hipStream_t stream) {
    static int grid = 0;
    if (grid == 0) {
        if (n_in != 16 || ws_size < WS_END) { fprintf(stderr, "kernel_launch: bad arguments n_in %d ws %zu need %zu\n", n_in, ws_size, (size_t)WS_END); grid = -1; return; }
        int dev = 0, cus = 0, per_cu = 0;
        if (hipGetDevice(&dev) != hipSuccess || hipDeviceGetAttribute(&cus, hipDeviceAttributeMultiprocessorCount, dev) != hipSuccess) { grid = -1; return; }
        if (hipFuncSetAttribute((const void*)k_mega, hipFuncAttributeMaxDynamicSharedMemorySize, LDS_TOTAL) != hipSuccess) { fprintf(stderr, "kernel_launch: hipFuncSetAttribute failed\n"); grid = -1; return; }
        if (hipOccupancyMaxActiveBlocksPerMultiprocessor(&per_cu, (const void*)k_mega, 512, LDS_TOTAL) != hipSuccess || per_cu < 1) { fprintf(stderr, "kernel_launch: occupancy query says %d\n", per_cu); }
        (void)hipGetLastError();
        grid = cus > 0 ? cus : 256;
    }
    if (grid < 0) return;
    if (hipMemsetAsync((char*)d_ws + WS_CTL, 0, CTL_BYTES, stream) != hipSuccess) return;
    Params p{};
    p.x_in = (const float*)d_in[0]; p.w_in = (const float*)d_in[1]; p.fbias = (const float*)d_in[2]; p.dlam = (const float*)d_in[3]; p.subln = (const float*)d_in[4];
    p.cpos = (const float*)d_in[5]; p.cw1 = (const float*)d_in[6]; p.cw2 = (const float*)d_in[7]; p.wbf = (const float*)d_in[8]; p.wbd = (const float*)d_in[9];
    p.wbn = (const float*)d_in[10]; p.wgate = (const float*)d_in[11]; p.wout = (const float*)d_in[12]; p.gains = (const float*)d_in[13]; p.wup = (const float*)d_in[14];
    p.wdn = (const float*)d_in[15]; p.xo = (float*)d_out; p.ws = (unsigned char*)d_ws;
    hipLaunchKernelGGL(k_mega, dim3(grid), dim3(512), LDS_TOTAL, stream, p);
}
```
